# Optimizing an MI355X kernel written in HIP

```python
import jax, jax.numpy as jnp
from jax import lax
import numpy as np

D_MODEL = 1024
BATCH = 8
SEQ = 4096
DEPTH = 2

CHUNK = 64
N_MIXERS = 2
CONV_WIDTH = 31
GMLP_BLOCK = 128
GMLP_INNER = 2 * D_MODEL
GMLP_HEADS = 8
GMLP_HEAD_DIM = GMLP_INNER // GMLP_HEADS
N_GROUPS = 4
EXPERTS_PER_GROUP = 8
N_EXPERTS = N_GROUPS * EXPERTS_PER_GROUP
GROUP_TOP_K = 1
TOP_K = 2
D_EXPERT = D_MODEL // 2
ROW_BLOCK = 128
EPS = 1e-6

kernel_name = "hybrid_conv_gmlp_hier_moe"


def rmsnorm(x, g):
    xf = x.astype(jnp.float32)
    y = xf * lax.rsqrt(jnp.mean(xf * xf, axis=-1, keepdims=True) + EPS)
    return (y * g.astype(jnp.float32)).astype(x.dtype)


def layernorm(x, g, b):
    xf = x.astype(jnp.float32)
    mu = jnp.mean(xf, axis=-1, keepdims=True)
    xc = xf - mu
    y = xc * lax.rsqrt(jnp.mean(xc * xc, axis=-1, keepdims=True) + EPS)
    return (y * g.astype(jnp.float32) + b.astype(jnp.float32)).astype(x.dtype)


def conv_module(h, w_pw1, b_pw1, w_dw, b_dw, ln_g, ln_b, w_pw2, b_pw2):
    a, gate = jnp.split(h @ w_pw1 + b_pw1, 2, axis=-1)
    z = a * jax.nn.sigmoid(gate)
    z = lax.conv_general_dilated(
        z, w_dw[:, None, :].astype(z.dtype), window_strides=(1,),
        padding=[(CONV_WIDTH - 1, 0)],
        dimension_numbers=("NWC", "WIO", "NWC"),
        feature_group_count=z.shape[-1]) + b_dw
    z = jax.nn.silu(layernorm(z, ln_g, ln_b))
    return z @ w_pw2 + b_pw2


def chunk_causal_mask():
    i = jnp.arange(GMLP_BLOCK)
    return (i[None, :] // CHUNK) <= (i[:, None] // CHUNK)


def gmlp_module(h, w_in, b_in, v_norm_g, w_s, b_s, w_out, b_out):
    B, S, _ = h.shape
    z = jax.nn.gelu(h @ w_in + b_in)
    u, v = jnp.split(z, 2, axis=-1)
    v = rmsnorm(v, v_norm_g)
    v = v.reshape(B, S // GMLP_BLOCK, GMLP_BLOCK, GMLP_HEADS, GMLP_HEAD_DIM)
    ws = jnp.where(chunk_causal_mask()[None], w_s, jnp.zeros_like(w_s)).astype(v.dtype)
    sv = jnp.einsum("hij,bnjhc->bnihc", ws, v) + jnp.transpose(b_s)[:, :, None].astype(v.dtype)
    return (u * sv.reshape(B, S, GMLP_INNER)) @ w_out + b_out


def hier_moe(x2, w_group, b_group, w_expert, b_expert, w_gate, w_up, w_down):
    T, D = x2.shape
    lg = (x2 @ w_group + b_group).astype(jnp.float32)
    p_group = jax.nn.softmax(lg, axis=-1)
    g_sel = jnp.argmax(lg, axis=-1).astype(jnp.int32)
    p_g = jnp.take_along_axis(p_group, g_sel[:, None], axis=-1)
    le = (x2 @ w_expert + b_expert).astype(jnp.float32).reshape(T, N_GROUPS, EXPERTS_PER_GROUP)
    le = jnp.take_along_axis(le, g_sel[:, None, None], axis=1)[:, 0]
    top_v, top_i = lax.top_k(le, TOP_K)
    gates = p_g * jax.nn.softmax(top_v, axis=-1)
    expert = g_sel[:, None] * EXPERTS_PER_GROUP + top_i.astype(jnp.int32)

    A = T * TOP_K
    e_flat = expert.reshape(A)
    w_flat = gates.reshape(A)
    tok_flat = jnp.arange(A, dtype=jnp.int32) // TOP_K
    order = jnp.argsort(e_flat)
    e_s, tok_s, w_s = e_flat[order], tok_flat[order], w_flat[order]
    counts = jnp.bincount(e_flat, length=N_EXPERTS).astype(jnp.int32)
    padded = ((counts + ROW_BLOCK - 1) // ROW_BLOCK) * ROW_BLOCK
    start = jnp.cumsum(counts) - counts
    pend = jnp.cumsum(padded)
    pstart = pend - padded
    dest = pstart[e_s] + (jnp.arange(A, dtype=jnp.int32) - start[e_s])
    n_blocks = (A + ROW_BLOCK - 1) // ROW_BLOCK + N_EXPERTS
    R = n_blocks * ROW_BLOCK
    rows = jnp.zeros((R, D), x2.dtype).at[dest].set(x2[tok_s])
    row_tok = jnp.zeros((R,), jnp.int32).at[dest].set(tok_s)
    row_w = jnp.zeros((R,), jnp.float32).at[dest].set(w_s)
    block_expert = jnp.minimum(
        jnp.searchsorted(pend, jnp.arange(n_blocks, dtype=jnp.int32) * ROW_BLOCK, side="right"),
        N_EXPERTS - 1).astype(jnp.int32)

    def expert_block(args):
        xb, e = args
        hb = jax.nn.silu(xb @ w_gate[e]) * (xb @ w_up[e])
        return hb @ w_down[e]

    out = lax.map(expert_block, (rows.reshape(n_blocks, ROW_BLOCK, D), block_expert))
    out = out.reshape(R, D) * row_w[:, None].astype(out.dtype)
    return jnp.zeros((T, D), x2.dtype).at[row_tok].add(out)


def setup_inputs(seed: int = 0) -> dict:
    key = jax.random.key(seed)
    ks = iter(jax.random.split(key, 40))

    def nrm(shape, scale):
        return scale * jax.random.normal(next(ks), shape, jnp.float32)

    D = D_MODEL
    n_a = (DEPTH + 1) // 2
    n_b = DEPTH // 2
    return {
        "x": nrm((BATCH, SEQ, D), 1.0),
        "norm_mix_g": 1.0 + nrm((DEPTH, D), 0.02),
        "norm_ffn_g": 1.0 + nrm((DEPTH, D), 0.02),
        "cv_w_pw1": nrm((n_a, D, 2 * D), D ** -0.5),
        "cv_b_pw1": nrm((n_a, 2 * D), 0.02),
        "cv_w_dw": nrm((n_a, CONV_WIDTH, D), CONV_WIDTH ** -0.5),
        "cv_b_dw": nrm((n_a, D), 0.02),
        "cv_ln_g": 1.0 + nrm((n_a, D), 0.02),
        "cv_ln_b": nrm((n_a, D), 0.02),
        "cv_w_pw2": nrm((n_a, D, D), D ** -0.5),
        "cv_b_pw2": nrm((n_a, D), 0.02),
        "gm_w_in": nrm((n_b, D, 2 * GMLP_INNER), D ** -0.5),
        "gm_b_in": nrm((n_b, 2 * GMLP_INNER), 0.02),
        "gm_v_norm_g": 1.0 + nrm((n_b, GMLP_INNER), 0.02),
        "gm_w_s": nrm((n_b, GMLP_HEADS, GMLP_BLOCK, GMLP_BLOCK), GMLP_BLOCK ** -0.5),
        "gm_b_s": 1.0 + nrm((n_b, GMLP_HEADS, GMLP_BLOCK), 0.02),
        "gm_w_out": nrm((n_b, GMLP_INNER, D), GMLP_INNER ** -0.5),
        "gm_b_out": nrm((n_b, D), 0.02),
        "moe_w_group": nrm((DEPTH, D, N_GROUPS), D ** -0.5),
        "moe_b_group": nrm((DEPTH, N_GROUPS), 0.01),
        "moe_w_expert": nrm((DEPTH, D, N_EXPERTS), D ** -0.5),
        "moe_b_expert": nrm((DEPTH, N_EXPERTS), 0.01),
        "moe_w_gate": nrm((DEPTH, N_EXPERTS, D, D_EXPERT), D ** -0.5),
        "moe_w_up": nrm((DEPTH, N_EXPERTS, D, D_EXPERT), D ** -0.5),
        "moe_w_down": nrm((DEPTH, N_EXPERTS, D_EXPERT, D), D_EXPERT ** -0.5),
        "final_g": 1.0 + nrm((D,), 0.02),
    }


def reference(x, norm_mix_g, norm_ffn_g,
              cv_w_pw1, cv_b_pw1, cv_w_dw, cv_b_dw, cv_ln_g, cv_ln_b, cv_w_pw2, cv_b_pw2,
              gm_w_in, gm_b_in, gm_v_norm_g, gm_w_s, gm_b_s, gm_w_out, gm_b_out,
              moe_w_group, moe_b_group, moe_w_expert, moe_b_expert,
              moe_w_gate, moe_w_up, moe_w_down, final_g):
    h = x
    B, S, D = h.shape
    for i in range(DEPTH):
        hn = rmsnorm(h, norm_mix_g[i])
        j = i // N_MIXERS
        if i % N_MIXERS == 0:
            m = conv_module(hn, cv_w_pw1[j], cv_b_pw1[j], cv_w_dw[j], cv_b_dw[j],
                            cv_ln_g[j], cv_ln_b[j], cv_w_pw2[j], cv_b_pw2[j])
        else:
            m = gmlp_module(hn, gm_w_in[j], gm_b_in[j], gm_v_norm_g[j], gm_w_s[j],
                            gm_b_s[j], gm_w_out[j], gm_b_out[j])
        h = h + m
        hn = rmsnorm(h, norm_ffn_g[i])
        y = hier_moe(hn.reshape(B * S, D), moe_w_group[i], moe_b_group[i],
                     moe_w_expert[i], moe_b_expert[i], moe_w_gate[i], moe_w_up[i], moe_w_down[i])
        h = h + y.reshape(B, S, D)
    return rmsnorm(h, final_g)
```

```cpp
#include <hip/hip_runtime.h>
#include <cstdio>
#include <cstdint>

#define GAS __attribute__((address_space(1)))
#define LAS __attribute__((address_space(3)))
typedef unsigned short bf16;
typedef unsigned v4u __attribute__((ext_vector_type(4)));
typedef unsigned v2u __attribute__((ext_vector_type(2)));
typedef float f32x4 __attribute__((ext_vector_type(4)));
typedef float f32x2 __attribute__((ext_vector_type(2)));
typedef short bf16x8 __attribute__((ext_vector_type(8)));

constexpr int BATCH = 8, SEQ = 4096, D = 1024, T = BATCH * SEQ;
constexpr int CONVW = 31, GI = 2048, GH = 8, GHD = 256, GB = 128;
constexpr int NG = 4, EPG = 8, NE = 32, DE = 512;
constexpr int LISTCAP = 32768;
constexpr float EPS = 1e-6f;
constexpr int NTHREADS = 512, NWAVES = 8;
constexpr int RING_BYTES = 131072, EPI_ROW_OFF = 131072 + 2048, EPI_BIAS_OFF = 131072 + 8192;

enum { I_X = 0, I_NMG, I_NFG, I_CW1, I_CB1, I_CDW, I_CDB, I_CLG, I_CLB, I_CW2, I_CB2, I_GWIN, I_GBIN, I_GVG, I_GWS, I_GBS, I_GWOUT, I_GBOUT,
       I_MWG, I_MBG, I_MWE, I_MBE, I_MGATE, I_MUP, I_MDOWN, I_FG, N_IN };

constexpr size_t MiB = 1u << 20;
constexpr size_t WS_CTL = 0, CTL_ZERO_BYTES = 64 * 1024;
constexpr size_t WS_W1T = 2 * MiB;
constexpr size_t WS_W2T = 6 * MiB;
constexpr size_t WS_WINT = 8 * MiB;
constexpr size_t WS_WOUTT = 16 * MiB;
constexpr size_t WS_WRT = 20 * MiB;
constexpr size_t WS_WRB = WS_WRT + 512 * 1024;
constexpr size_t WS_WST = 21 * MiB;
constexpr size_t WS_LIST = 22 * MiB;
constexpr size_t WS_GW = 26 * MiB;
constexpr size_t WS_SSQ = 27 * MiB;
constexpr size_t WS_RROW = 26 * MiB + 512 * 1024;
constexpr size_t WS_SINK = 31 * MiB;
constexpr size_t WS_WGU = 32 * MiB;
constexpr size_t WS_XN8 = 64 * MiB;
constexpr size_t WS_WD = 96 * MiB;
constexpr size_t WS_GWL = 112 * MiB;
constexpr size_t WS_XN = 128 * MiB;
constexpr size_t WS_A = 192 * MiB;
constexpr size_t WS_B = 320 * MiB;
constexpr size_t WS_H = 448 * MiB;
constexpr size_t WS_END = 512 * MiB;
constexpr int CW_CNT = 1024;
constexpr int CW_BAR = 8192;
constexpr int CW_WMAX = 12288;
constexpr int WL_WIN = 0, WL_W1 = 128, WL_W2 = 192;

__device__ __forceinline__ unsigned f2bf(float f) { unsigned u = __builtin_bit_cast(unsigned, f); return (u + 0x7fffu + ((u >> 16) & 1u)) >> 16; }
__device__ __forceinline__ float bf2f(unsigned b) { return __builtin_bit_cast(float, b << 16); }
__device__ __forceinline__ unsigned pk2(float lo, float hi) { return f2bf(lo) | (f2bf(hi) << 16); }
__device__ __forceinline__ float bflo(unsigned w) { return __builtin_bit_cast(float, w << 16); }
__device__ __forceinline__ float bfhi(unsigned w) { return __builtin_bit_cast(float, w & 0xffff0000u); }
__device__ __forceinline__ float wave_sum(float v) {
#pragma unroll
    for (int o = 1; o < 64; o <<= 1) v += __shfl_xor(v, o);
    return v;
}
__device__ __forceinline__ float sigmoidf_(float x) { return 1.0f / (1.0f + __expf(-x)); }
__device__ __forceinline__ float gelu_tanh(float x) { const float u = 1.5957691216f * (x + 0.044715f * x * x * x); return x / (1.0f + __expf(-u)); }

namespace pg8 {
__device__ __forceinline__ unsigned cvt_pk_bf16(float lo, float hi) { unsigned r; asm volatile("v_cvt_pk_bf16_f32 %0, %1, %2" : "=v"(r) : "v"(lo), "v"(hi)); return r; }
__device__ __forceinline__ float fsig(float x) { return __builtin_amdgcn_rcpf(1.0f + __builtin_amdgcn_exp2f(-1.4426950409f * x)); }
__device__ __forceinline__ f32x4 fsig4(f32x4 x) { f32x4 r; r.x = fsig(x.x); r.y = fsig(x.y); r.z = fsig(x.z); r.w = fsig(x.w); return r; }
template <bool GELU> __device__ __forceinline__ void act_poly8(f32x4& v0, f32x4& v1) {
    constexpr float L = GELU ? 4.0f : 7.0f;
    constexpr float c0 = GELU ? 3.9687074012e-01f : 2.4690736109e-01f, c1 = GELU ? -6.2763353285e-02f : -1.7827826460e-02f, c2 = GELU ? 7.8253311655e-03f : 1.1278641748e-03f,
                    c3 = GELU ? -6.025413863e-04f : -4.6268168782e-05f, c4 = GELU ? 2.5222551098e-05f : 1.1232122267e-06f, c5 = GELU ? -4.348902567e-07f : -1.4550269506e-08f, c6 = GELU ? 0.0f : 7.7191484876e-11f;
    f32x2 x[4] = {{v0.x, v0.y}, {v0.z, v0.w}, {v1.x, v1.y}, {v1.z, v1.w}}, xc[4], t[4], t2[4], qa[4], qb[4], qc[4];
#pragma unroll
    for (int i = 0; i < 4; ++i) { xc[i].x = __builtin_amdgcn_fmed3f(x[i].x, -L, L); xc[i].y = __builtin_amdgcn_fmed3f(x[i].y, -L, L); }
#pragma unroll
    for (int i = 0; i < 4; ++i) t[i] = xc[i] * xc[i];
#pragma unroll
    for (int i = 0; i < 4; ++i) { t2[i] = t[i] * t[i]; qa[i] = t[i] * c1 + c0; qb[i] = t[i] * c3 + c2; qc[i] = t[i] * c5 + c4; }
    if (!GELU) {
#pragma unroll
        for (int i = 0; i < 4; ++i) qc[i] = t2[i] * c6 + qc[i];
    }
#pragma unroll
    for (int i = 0; i < 4; ++i) qb[i] = qc[i] * t2[i] + qb[i];
#pragma unroll
    for (int i = 0; i < 4; ++i) qa[i] = qb[i] * t2[i] + qa[i];
#pragma unroll
    for (int i = 0; i < 4; ++i) { qa[i] = qa[i] * xc[i] + 0.5f; if (GELU) qa[i] = qa[i] * x[i]; }
    v0 = (f32x4){qa[0].x, qa[0].y, qa[1].x, qa[1].y}; v1 = (f32x4){qa[2].x, qa[2].y, qa[3].x, qa[3].y};
}
__device__ __forceinline__ unsigned pack4_fp8(f32x4 a) { unsigned w = 0u; w = (unsigned)__builtin_amdgcn_cvt_pk_fp8_f32(a.x, a.y, (int)w, false); w = (unsigned)__builtin_amdgcn_cvt_pk_fp8_f32(a.z, a.w, (int)w, true); return w; }
__device__ __forceinline__ v4u pack8(f32x4 a, f32x4 b) { v4u w; w.x = cvt_pk_bf16(a.x, a.y); w.y = cvt_pk_bf16(a.z, a.w); w.z = cvt_pk_bf16(b.x, b.y); w.w = cvt_pk_bf16(b.z, b.w); return w; }
}

__device__ __forceinline__ unsigned pack4_i8(f32x4 v, float inv) {
    const int a = (int)__builtin_rintf(v.x * inv), b = (int)__builtin_rintf(v.y * inv), c = (int)__builtin_rintf(v.z * inv), d = (int)__builtin_rintf(v.w * inv);
    return (unsigned)(a & 255) | ((unsigned)(b & 255) << 8) | ((unsigned)(c & 255) << 16) | ((unsigned)d << 24);
}
__device__ __forceinline__ float wave_max(float v) {
#pragma unroll
    for (int o = 1; o < 64; o <<= 1) v = fmaxf(v, __shfl_xor(v, o));
    return v;
}

struct Params { const float* in[N_IN]; float* out; unsigned char* ws; int ph_lo, ph_hi, dry, pad; };

struct Frame {
    LAS unsigned char* lds;
    int tid, lane, wave, wg, nwg;
    Params p;
    unsigned char* ws;
};
__device__ __forceinline__ unsigned* ctl(const Frame& F) { return (unsigned*)(F.ws + WS_CTL); }

__device__ __forceinline__ void transpose_item(const float* W, int ldn, int K, bf16* WT, int k0, int n0, int dst_r0, LAS float* scr, int lane, const float* kscale = nullptr) {
#pragma unroll 8
    for (int i = 0; i < 32; ++i) { const int kk = 2 * i + (lane >> 5); float x = W[(size_t)(k0 + kk) * ldn + n0 + (lane & 31)]; if (kscale) x *= kscale[k0 + kk]; scr[kk * 33 + (lane & 31)] = x; }
    asm volatile("s_waitcnt lgkmcnt(0)" ::: "memory");
    const int c = lane & 7;
#pragma unroll
    for (int j = 0; j < 4; ++j) { const int n = (lane >> 3) + 8 * j; const LAS float* s = scr + (8 * c) * 33 + n;
        v4u o; o.x = pk2(s[0 * 33], s[1 * 33]); o.y = pk2(s[2 * 33], s[3 * 33]); o.z = pk2(s[4 * 33], s[5 * 33]); o.w = pk2(s[6 * 33], s[7 * 33]);
        *(v4u*)(WT + (size_t)(dst_r0 + n) * K + k0 + 8 * c) = o; }
    asm volatile("s_waitcnt lgkmcnt(0)" ::: "memory");
}
__device__ __forceinline__ int glu_row(int n, int nh) { return ((n % nh) / 128) * 256 + (n / nh) * 128 + (n % 128); }

__device__ __forceinline__ void transpose_item8(const float* W, int ldn, int K, unsigned char* WT8, int k0, int n0, int dst_r0, float scale, LAS float* scr, int lane) {
#pragma unroll 8
    for (int i = 0; i < 32; ++i) { const int kk = 2 * i + (lane >> 5); scr[kk * 33 + (lane & 31)] = W[(size_t)(k0 + kk) * ldn + n0 + (lane & 31)]; }
    asm volatile("s_waitcnt lgkmcnt(0)" ::: "memory");
    const int c = lane & 7;
#pragma unroll
    for (int j = 0; j < 4; ++j) { const int n = (lane >> 3) + 8 * j; const LAS float* sp = scr + (8 * c) * 33 + n;
        v2u o; o.x = pg8::pack4_fp8((f32x4){sp[0 * 33] * scale, sp[1 * 33] * scale, sp[2 * 33] * scale, sp[3 * 33] * scale}); o.y = pg8::pack4_fp8((f32x4){sp[4 * 33] * scale, sp[5 * 33] * scale, sp[6 * 33] * scale, sp[7 * 33] * scale});
        *(v2u*)(WT8 + (size_t)(dst_r0 + n) * K + k0 + 8 * c) = o; }
    asm volatile("s_waitcnt lgkmcnt(0)" ::: "memory");
}
template <bool KS> __device__ __forceinline__ void transpose_item_i8(const float* W, int ldn, int K, unsigned char* WT8, int k0, int n0, int dst_r0, const float* kscale, float inv, LAS float* scr, int lane) {
    float gl = 1.0f; if constexpr (KS) gl = kscale[k0 + lane];
#pragma unroll 8
    for (int i = 0; i < 32; ++i) { const int kk = 2 * i + (lane >> 5); float w = W[(size_t)(k0 + kk) * ldn + n0 + (lane & 31)];
        if constexpr (KS) { const float g0 = __builtin_bit_cast(float, __builtin_amdgcn_readlane(__builtin_bit_cast(int, gl), 2 * i)), g1 = __builtin_bit_cast(float, __builtin_amdgcn_readlane(__builtin_bit_cast(int, gl), 2 * i + 1)); w *= lane < 32 ? g0 : g1; }
        scr[kk * 33 + (lane & 31)] = w; }
    asm volatile("s_waitcnt lgkmcnt(0)" ::: "memory");
    const int c = lane & 7;
#pragma unroll
    for (int j = 0; j < 4; ++j) { const int n = (lane >> 3) + 8 * j; const LAS float* sp = scr + (8 * c) * 33 + n;
        v2u o; o.x = pack4_i8((f32x4){sp[0 * 33], sp[1 * 33], sp[2 * 33], sp[3 * 33]}, inv); o.y = pack4_i8((f32x4){sp[4 * 33], sp[5 * 33], sp[6 * 33], sp[7 * 33]}, inv);
        *(v2u*)(WT8 + (size_t)(dst_r0 + n) * K + k0 + 8 * c) = o; }
    asm volatile("s_waitcnt lgkmcnt(0)" ::: "memory");
}
template <bool KS> __device__ __forceinline__ void wmax_item(const Frame& F, const float* W, int ldn, int k0, int n0, const float* kscale, int line) {
    float mx = 0.f, gl = 1.0f; if constexpr (KS) gl = kscale[k0 + F.lane];
#pragma unroll
    for (int i = 0; i < 32; ++i) { const int kk = k0 + 2 * i + (F.lane >> 5); float w = W[(size_t)kk * ldn + n0 + (F.lane & 31)];
        if constexpr (KS) { const float g0 = __builtin_bit_cast(float, __builtin_amdgcn_readlane(__builtin_bit_cast(int, gl), 2 * i)), g1 = __builtin_bit_cast(float, __builtin_amdgcn_readlane(__builtin_bit_cast(int, gl), 2 * i + 1)); w *= F.lane < 32 ? g0 : g1; }
        mx = fmaxf(mx, fabsf(w)); }
    mx = wave_max(mx); if (F.lane == 0) atomicMax(ctl(F) + CW_WMAX + line * 16, __float_as_uint(mx));
}
__device__ __forceinline__ float wmax8(const unsigned* lines) { float m = 0.f;
#pragma unroll
    for (int q = 0; q < 8; ++q) m = fmaxf(m, __uint_as_float(lines[q * 16])); return m > 0.f ? m : 1.0f; }
__device__ __forceinline__ float unit_wmax(const Frame& F, int line0) { return wmax8(ctl(F) + CW_WMAX + line0 * 16); }
__device__ __forceinline__ void convert_win_i8(Frame& F) {
    LAS float* scr = (LAS float*)(F.lds + F.wave * 16384);
    const int gw = F.wg * NWAVES + F.wave, NGW = F.nwg * NWAVES;
    for (int it = gw; it < 16 * 128; it += NGW) { const int kb = it / 128, nb = it % 128;
        transpose_item_i8<true>(F.p.in[I_GWIN], 4096, D, F.ws + WS_WINT, kb * 64, nb * 32, nb * 32, F.p.in[I_NMG] + D, 127.0f / unit_wmax(F, WL_WIN + (nb >> 3) * 8), scr, F.lane); }
}
constexpr float Y_SCALE = 16.0f;
constexpr float MOE_WSCALE = 1.0f;
__device__ __forceinline__ void convert_moe_layer(Frame& F, int layer) {
    const float* wg = F.p.in[I_MGATE] + (size_t)layer * NE * D * DE;
    const float* wu = F.p.in[I_MUP] + (size_t)layer * NE * D * DE;
    const float* wd = F.p.in[I_MDOWN] + (size_t)layer * NE * DE * D;
    unsigned char* WGU = F.ws + WS_WGU; unsigned char* WD = F.ws + WS_WD;
    const int w = F.wave, lane = F.lane;
    constexpr int TPE = 96, NT = NE * TPE;
    const unsigned ldsb = (unsigned)(size_t)F.lds;
    auto stage = [&](const int ti, const int b) __attribute__((always_inline)) {
        const int e = ti / TPE, r = ti % TPE; const float* src; int ldn;
        if (r < 64) { const int up = r >> 5, q = r & 31, kb = q >> 1, nb = q & 1; src = (up ? wu : wg) + (size_t)e * D * DE + (size_t)(kb * 64) * DE + nb * 256; ldn = DE; }
        else { const int q = r - 64, kb = q >> 2, nb = q & 3; src = wd + (size_t)e * DE * D + (size_t)(kb * 64) * D + nb * 256; ldn = D; }
        const unsigned voff = (unsigned)((lane ^ w) * 16);
#pragma unroll
        for (int i = 0; i < 8; ++i) { const float* rowp = src + (size_t)(8 * w + i) * ldn; const unsigned m0v = ldsb + (unsigned)(b * 65536 + (8 * w + i) * 1024);
            asm volatile("s_mov_b32 m0, %2\n\ts_nop 0\n\tglobal_load_lds_dwordx4 %0, %1" :: "v"(voff), "s"(rowp), "s"(m0v) : "memory", "m0"); }
    };
    auto emit = [&](const int ti, const int b) __attribute__((always_inline)) {
        const int e = ti / TPE, r = ti % TPE; unsigned char* dst; int pitch, drow;
        if (r < 64) { const int up = r >> 5, q = r & 31, kb = q >> 1, nb = q & 1, n0 = nb * 256 + 32 * w; dst = WGU + (size_t)e * D * D + kb * 64; pitch = D; drow = (n0 / 128) * 256 + up * 128 + (n0 % 128); }
        else { const int q = r - 64, kb = q >> 2, nb = q & 3; dst = WD + (size_t)e * D * DE + kb * 64; pitch = DE; drow = nb * 256 + 32 * w; }
        const int c = lane & 7; const LAS unsigned char* buf = F.lds + b * 65536 + (8 * c) * 1024;
#pragma unroll
        for (int j = 0; j < 4; ++j) { const int nl = (lane >> 3) + 8 * j; const LAS float* sp = (const LAS float*)(buf + (((8 * w + (nl >> 2)) ^ c) * 16) + (nl & 3) * 4);
            v2u o; o.x = pg8::pack4_fp8((f32x4){sp[0] * MOE_WSCALE, sp[256] * MOE_WSCALE, sp[512] * MOE_WSCALE, sp[768] * MOE_WSCALE}); o.y = pg8::pack4_fp8((f32x4){sp[1024] * MOE_WSCALE, sp[1280] * MOE_WSCALE, sp[1536] * MOE_WSCALE, sp[1792] * MOE_WSCALE});
            *(v2u*)(dst + (size_t)(drow + nl) * pitch + 8 * c) = o; }
    };
    __syncthreads();
    int ti = F.wg, b = 0;
    if (ti < NT) stage(ti, 0);
    for (; ti < NT; ti += F.nwg, b ^= 1) {
        const int tn = ti + F.nwg;
        if (tn < NT) { stage(tn, b ^ 1); asm volatile("s_waitcnt vmcnt(8)" ::: "memory"); }
        else asm volatile("s_waitcnt vmcnt(0)" ::: "memory");
        __syncthreads();
        emit(ti, b);
        asm volatile("s_waitcnt lgkmcnt(0)" ::: "memory");
        __syncthreads();
    }
}
__device__ __forceinline__ void rms_row_to_bf16(const float* xrow, const float* g, bf16* orow, int lane) {
    const f32x4* xr = (const f32x4*)xrow + lane; const f32x4* gr = (const f32x4*)g + lane;
    f32x4 v[4]; float s = 0.f;
#pragma unroll
    for (int j = 0; j < 4; ++j) { v[j] = xr[64 * j]; s += (v[j].x * v[j].x + v[j].y * v[j].y) + (v[j].z * v[j].z + v[j].w * v[j].w); }
    const float r = 1.0f / sqrtf(wave_sum(s) * (1.0f / D) + EPS);
    v2u* o8 = (v2u*)orow + lane;
#pragma unroll
    for (int j = 0; j < 4; ++j) { const f32x4 gg = gr[64 * j]; v2u w; w.x = pk2(v[j].x * r * gg.x, v[j].y * r * gg.y); w.y = pk2(v[j].z * r * gg.z, v[j].w * r * gg.w); o8[64 * j] = w; }
}
__device__ __forceinline__ void phase_prologue(Frame& F) {
    LAS float* scr = (LAS float*)(F.lds + F.wave * 16384);
    const int gw = F.wg * NWAVES + F.wave, NGW = F.nwg * NWAVES;
    constexpr int I1 = 16 * 64, I2 = 16 * 32, I3 = 16 * 128, I4 = 32 * 32;
    for (int it = gw; it < I1 + I2 + I3 + I4; it += NGW) {
        int r = it;
        if (r < I1) { const int kb = r / 64, nb = r % 64; wmax_item<false>(F, F.p.in[I_CW1], 2048, kb * 64, nb * 32, nullptr, WL_W1 + (glu_row(nb * 32, 1024) >> 8) * 8 + (kb & 7)); continue; } r -= I1;
        if (r < I2) { const int kb = r / 32, nb = r % 32; wmax_item<false>(F, F.p.in[I_CW2], D, kb * 64, nb * 32, nullptr, WL_W2 + (nb >> 3) * 8 + (kb & 7)); continue; } r -= I2;
        if (r < I3) { const int kb = r / 128, nb = r % 128; wmax_item<true>(F, F.p.in[I_GWIN], 4096, kb * 64, nb * 32, F.p.in[I_NMG] + D, WL_WIN + (nb >> 3) * 8 + (kb & 7)); continue; } r -= I3;
        { const int kb = r / 32, nb = r % 32; transpose_item(F.p.in[I_GWOUT], D, GI, (bf16*)(F.ws + WS_WOUTT), kb * 64, nb * 32, nb * 32, scr, F.lane); }
    }
    const int gt = F.wg * NTHREADS + F.tid, NGT = F.nwg * NTHREADS;
    bf16* WRB = (bf16*)(F.ws + WS_WRB);
    for (int i = gt; i < 2 * 48 * D; i += NGT) { const int l = i / (48 * D), o = (i / D) % 48, k = i % D;
        const float gk = F.p.in[I_NFG][l * D + k];
        WRB[i] = (bf16)(o < 4 ? f2bf(gk * F.p.in[I_MWG][((size_t)l * D + k) * NG + o]) : o < 36 ? f2bf(gk * F.p.in[I_MWE][((size_t)l * D + k) * NE + (o - 4)]) : 0u); }
    bf16* WST = (bf16*)(F.ws + WS_WST);
    for (int i = gt; i < GH * GB * GB; i += NGT) { const int ii = (i / GB) % GB, j = i % GB; WST[i] = (bf16)((j / 64 <= ii / 64) ? f2bf(F.p.in[I_GWS][i]) : 0u); }
    unsigned char* XN = F.ws + WS_XN; float* RROW = (float*)(F.ws + WS_RROW);
    {
        const float* X = F.p.in[I_X]; const int lane = F.lane;
        f32x4 gg[4], nx[4];
#pragma unroll
        for (int j = 0; j < 4; ++j) gg[j] = ((const f32x4*)F.p.in[I_NMG])[lane + 64 * j];
        if (gw < T) {
#pragma unroll
            for (int j = 0; j < 4; ++j) nx[j] = ((const f32x4*)(X + (size_t)gw * D))[lane + 64 * j]; }
        auto xrow = [&](const int m) __attribute__((always_inline)) {
            const int mn = m + NGW < T ? m + NGW : m;
            f32x4 v[4]; float ss = 0.f;
#pragma unroll
            for (int j = 0; j < 4; ++j) { v[j] = nx[j]; ss += (v[j].x * v[j].x + v[j].y * v[j].y) + (v[j].z * v[j].z + v[j].w * v[j].w); }
#pragma unroll
            for (int j = 0; j < 4; ++j) nx[j] = ((const f32x4*)(X + (size_t)mn * D))[lane + 64 * j];
            const float r = 1.0f / sqrtf(wave_sum(ss) * (1.0f / D) + EPS);
            float mx = 0.f;
#pragma unroll
            for (int j = 0; j < 4; ++j) { v[j] = v[j] * gg[j]; mx = fmaxf(fmaxf(mx, fmaxf(fabsf(v[j].x), fabsf(v[j].y))), fmaxf(fabsf(v[j].z), fabsf(v[j].w))); }
            mx = wave_max(mx); mx = mx > 0.f ? mx : 1.0f; const float inv = 127.0f / mx;
            unsigned* o8 = (unsigned*)(XN + (size_t)m * D) + lane;
#pragma unroll
            for (int j = 0; j < 4; ++j) o8[64 * j] = pack4_i8(v[j], inv);
            if (lane == 0) RROW[m] = r * mx * (1.0f / 127.0f);
        };
        if (gw < T) xrow(gw);
        for (int m = gw + NGW; m < T; m += NGW) xrow(m);
    }
}

__device__ __forceinline__ void phase_prologue2(Frame& F) {
    LAS float* scr = (LAS float*)(F.lds + F.wave * 16384);
    const int gw = F.wg * NWAVES + F.wave, NGW = F.nwg * NWAVES;
    constexpr int I1 = 16 * 64, I2 = 16 * 32;
    for (int it = gw; it < I1 + I2; it += NGW) {
        int r = it;
        if (r < I1) { const int kb = r / 64, nb = r % 64, dr = glu_row(nb * 32, 1024); transpose_item_i8<false>(F.p.in[I_CW1], 2048, D, F.ws + WS_W1T, kb * 64, nb * 32, dr, nullptr, 127.0f / unit_wmax(F, WL_W1 + (dr >> 8) * 8), scr, F.lane); continue; } r -= I1;
        { const int kb = r / 32, nb = r % 32; transpose_item_i8<false>(F.p.in[I_CW2], D, D, F.ws + WS_W2T, kb * 64, nb * 32, nb * 32, nullptr, 127.0f / unit_wmax(F, WL_W2 + (nb >> 3) * 8), scr, F.lane); }
    }
}

constexpr int CONV_TR = 32;
template <int S> __device__ __forceinline__ void conv_steps(f32x2 (&acc)[32], const f32x2 (&w)[31], const bf16* Z, int t0, int seq0, int c2) {
    if constexpr (S < 32 + 31 - 1) {
        const int row = t0 - 30 + S; const bool ok = row >= seq0;
        unsigned zz = *(const unsigned*)(Z + (size_t)(ok ? row : seq0) * D + c2); zz = ok ? zz : 0u;
        const f32x2 z = (f32x2){bflo(zz), bfhi(zz)};
        constexpr int OLO = S - 30 > 0 ? S - 30 : 0, OHI = S < 31 ? S : 31;
#pragma unroll
        for (int o = OLO; o <= OHI; ++o) acc[o] += w[S - o] * z;
        conv_steps<S + 1>(acc, w, Z, t0, seq0, c2);
    }
}
__device__ __forceinline__ void phase_conv(Frame& F) {
    LAS float* tile = (LAS float*)F.lds;
    const bf16* Z = (const bf16*)(F.ws + WS_A); unsigned char* ZC = F.ws + WS_A + 64 * MiB; float* RROW = (float*)(F.ws + WS_RROW);
    const float* wdw = F.p.in[I_CDW]; const float* bdw = F.p.in[I_CDB]; const float* lg = F.p.in[I_CLG]; const float* lb = F.p.in[I_CLB];
    const int lane = F.lane, c2 = F.tid * 2;
    f32x2 w[CONVW];
#pragma unroll
    for (int k = 0; k < CONVW; ++k) w[k] = *(const f32x2*)(wdw + k * D + c2);
    const f32x2 bias2 = *(const f32x2*)(bdw + c2);
    f32x4 g[4], bb[4];
#pragma unroll
    for (int h = 0; h < 2; ++h) { g[2 * h] = *(const f32x4*)(lg + h * 512 + 8 * lane); g[2 * h + 1] = *(const f32x4*)(lg + h * 512 + 8 * lane + 4);
        bb[2 * h] = *(const f32x4*)(lb + h * 512 + 8 * lane); bb[2 * h + 1] = *(const f32x4*)(lb + h * 512 + 8 * lane + 4); }
    for (int ti = F.wg; ti < T / CONV_TR; ti += F.nwg) {
        const int t0 = ti * CONV_TR, tl0 = t0 % SEQ, seq0 = t0 - tl0;
        f32x2 acc[CONV_TR];
#pragma unroll
        for (int o = 0; o < CONV_TR; ++o) acc[o] = bias2;
        conv_steps<0>(acc, w, Z, t0, seq0, c2);
        __syncthreads();
#pragma unroll
        for (int o = 0; o < CONV_TR; ++o) *(LAS f32x2*)(tile + o * D + c2) = acc[o];
        __syncthreads();
#pragma unroll
        for (int rr = 0; rr < CONV_TR / NWAVES; ++rr) {
            const int r = F.wave * (CONV_TR / NWAVES) + rr;
            f32x4 x[4];
#pragma unroll
            for (int h = 0; h < 2; ++h) { x[2 * h] = *(const LAS f32x4*)(tile + r * D + h * 512 + 8 * lane); x[2 * h + 1] = *(const LAS f32x4*)(tile + r * D + h * 512 + 8 * lane + 4); }
            float sm = 0.f;
#pragma unroll
            for (int j = 0; j < 4; ++j) sm += (x[j].x + x[j].y) + (x[j].z + x[j].w);
            const float mu = wave_sum(sm) * (1.0f / D); float q = 0.f;
#pragma unroll
            for (int j = 0; j < 4; ++j) { x[j] = x[j] - mu; q += (x[j].x * x[j].x + x[j].y * x[j].y) + (x[j].z * x[j].z + x[j].w * x[j].w); }
            const float rstd = 1.0f / sqrtf(wave_sum(q) * (1.0f / D) + EPS);
#pragma unroll
            for (int j = 0; j < 4; ++j) x[j] = x[j] * rstd * g[j] + bb[j];
            { f32x4 s0 = x[0], s1 = x[1], s2 = x[2], s3 = x[3]; pg8::act_poly8<false>(s0, s1); pg8::act_poly8<false>(s2, s3); x[0] = x[0] * s0; x[1] = x[1] * s1; x[2] = x[2] * s2; x[3] = x[3] * s3; }
            float mx = 0.f;
#pragma unroll
            for (int j = 0; j < 4; ++j) mx = fmaxf(fmaxf(mx, fmaxf(fabsf(x[j].x), fabsf(x[j].y))), fmaxf(fabsf(x[j].z), fabsf(x[j].w)));
            mx = wave_max(mx); mx = mx > 0.f ? mx : 1.0f; const float inv = 127.0f / mx;
            { v2u w0, w1; w0.x = pack4_i8(x[0], inv); w0.y = pack4_i8(x[1], inv); w1.x = pack4_i8(x[2], inv); w1.y = pack4_i8(x[3], inv);
              *(v2u*)(ZC + (size_t)(t0 + r) * D + 8 * lane) = w0; *(v2u*)(ZC + (size_t)(t0 + r) * D + 512 + 8 * lane) = w1; }
            if (lane == 0) RROW[t0 + r] = mx * (1.0f / 127.0f);
        }
    }
}

template <bool HIN_F32> __device__ __forceinline__ void phase_route(Frame& F, int layer, int cslot, const void* Hin_, const bf16* M) {
    LAS unsigned char* wimg = F.lds; LAS float* lgt = (LAS float*)(F.lds + 98304) + F.wave * (16 * 48);
    LAS unsigned* hist = (LAS unsigned*)(F.lds + 122880); LAS unsigned* base = (LAS unsigned*)(F.lds + 123008);
    LAS int* te = (LAS int*)(F.lds + 123136); LAS int* tr = (LAS int*)(F.lds + 124160); LAS float* tw = (LAS float*)(F.lds + 125184);
    bf16* H = (bf16*)(F.ws + WS_H); unsigned char* XN8 = F.ws + WS_XN8; LAS float* rtok = (LAS float*)(F.lds + 126208) + F.wave * 16;
    const float* Hf = (const float*)Hin_; const bf16* Hb = (const bf16*)Hin_;
    const float* g = F.p.in[I_NFG] + layer * D; const bf16* WRB = (const bf16*)(F.ws + WS_WRB) + (size_t)layer * 48 * D;
    const float* bg = F.p.in[I_MBG] + layer * NG; const float* be = F.p.in[I_MBE] + layer * NE;
    int* list = (int*)(F.ws + WS_LIST); float* gwt = (float*)(F.ws + WS_GWL); unsigned* cnt = ctl(F) + CW_CNT + cslot * 32 * 64;
    const int lane = F.lane, fr = lane & 15, fq = lane >> 4;
#pragma unroll
    for (int i = 0; i < 12; ++i) { const int p = F.tid + 512 * i, o = p >> 7, c = p & 127; *(LAS v4u*)(wimg + o * 2048 + 16 * (c ^ (o & 15))) = *(const v4u*)(WRB + (size_t)o * D + c * 8); }
    LAS float* rbias = (LAS float*)(F.lds + 126720);
    if (F.tid < 4) rbias[F.tid] = bg[F.tid]; else if (F.tid < 36) rbias[F.tid] = be[F.tid - 4];
    f32x4 gg[4];
#pragma unroll
    for (int j = 0; j < 4; ++j) gg[j] = ((const f32x4*)g)[lane + 64 * j];
    for (int chunk = F.wg; chunk < T / 128; chunk += F.nwg) {
        if (F.tid < 32) hist[F.tid] = 0u;
        __syncthreads();
        const int tbase = chunk * 128 + F.wave * 16;
        f32x4 nh[4]; v2u nhb[4], nm[4];
#pragma unroll
        for (int j = 0; j < 4; ++j) { if (HIN_F32) nh[j] = ((const f32x4*)(Hf + (size_t)tbase * D))[lane + 64 * j]; else nhb[j] = ((const v2u*)(Hb + (size_t)tbase * D))[lane + 64 * j];
            nm[j] = ((const v2u*)(M + (size_t)tbase * D))[lane + 64 * j]; }
        auto tok = [&](const int i) __attribute__((always_inline)) {
            const int t = tbase + i, tn = tbase + (i < 15 ? i + 1 : i);
            f32x4 v[4]; float s = 0.f;
#pragma unroll
            for (int j = 0; j < 4; ++j) { if (HIN_F32) v[j] = nh[j]; else v[j] = (f32x4){bflo(nhb[j].x), bfhi(nhb[j].x), bflo(nhb[j].y), bfhi(nhb[j].y)};
                v[j].x += bflo(nm[j].x); v[j].y += bfhi(nm[j].x); v[j].z += bflo(nm[j].y); v[j].w += bfhi(nm[j].y); }
#pragma unroll
            for (int j = 0; j < 4; ++j) { if (HIN_F32) nh[j] = ((const f32x4*)(Hf + (size_t)tn * D))[lane + 64 * j]; else nhb[j] = ((const v2u*)(Hb + (size_t)tn * D))[lane + 64 * j];
                nm[j] = ((const v2u*)(M + (size_t)tn * D))[lane + 64 * j]; }
#pragma unroll
            for (int j = 0; j < 4; ++j) { v2u hw; hw.x = pg8::cvt_pk_bf16(v[j].x, v[j].y); hw.y = pg8::cvt_pk_bf16(v[j].z, v[j].w); ((v2u*)(H + (size_t)t * D))[lane + 64 * j] = hw;
                s += (v[j].x * v[j].x + v[j].y * v[j].y) + (v[j].z * v[j].z + v[j].w * v[j].w); }
            const float r = 1.0f / sqrtf(wave_sum(s) * (1.0f / D) + EPS);
            unsigned* q8 = (unsigned*)(XN8 + (size_t)t * D) + lane;
#pragma unroll
            for (int j = 0; j < 4; ++j) q8[64 * j] = pg8::pack4_fp8(v[j] * r * gg[j]);
            if (lane == 0) rtok[i] = r;
        };
        tok(0);
        for (int i = 1; i < 16; ++i) tok(i);
        asm volatile("s_waitcnt vmcnt(0)" ::: "memory");
        f32x4 acc[3];
#pragma unroll
        for (int nt = 0; nt < 3; ++nt) acc[nt] = (f32x4){0.f, 0.f, 0.f, 0.f};
#pragma unroll
        for (int kh = 0; kh < 2; ++kh) {
            bf16x8 af[16];
#pragma unroll
            for (int k = 0; k < 16; ++k) af[k] = *(const bf16x8*)(H + (size_t)(tbase + fr) * D + 32 * (16 * kh + k) + 8 * fq);
            asm volatile("" : "+v"(af[0]), "+v"(af[1]), "+v"(af[2]), "+v"(af[3]), "+v"(af[4]), "+v"(af[5]), "+v"(af[6]), "+v"(af[7]), "+v"(af[8]), "+v"(af[9]), "+v"(af[10]), "+v"(af[11]), "+v"(af[12]), "+v"(af[13]), "+v"(af[14]), "+v"(af[15]));
#pragma unroll
            for (int k = 0; k < 16; ++k) { const int ks = 16 * kh + k;
#pragma unroll
                for (int nt = 0; nt < 3; ++nt) { const bf16x8 bfv = *(const LAS bf16x8*)(wimg + (16 * nt + fr) * 2048 + 16 * ((4 * ks + fq) ^ fr));
                    acc[nt] = __builtin_amdgcn_mfma_f32_16x16x32_bf16(af[k], bfv, acc[nt], 0, 0, 0); } }
        }
#pragma unroll
        for (int nt = 0; nt < 3; ++nt)
#pragma unroll
            for (int rg = 0; rg < 4; ++rg) lgt[(4 * fq + rg) * 48 + 16 * nt + fr] = acc[nt][rg];
        if (lane < 16) {
            const LAS float* lr = lgt + lane * 48; const float rt = rtok[lane];
            int gs = 0; float gm = lr[0] * rt + rbias[0]; float lg4[4]; lg4[0] = gm;
#pragma unroll
            for (int o = 1; o < 4; ++o) { lg4[o] = lr[o] * rt + rbias[o]; if (lg4[o] > gm) { gm = lg4[o]; gs = o; } }
            float den = 0.f;
#pragma unroll
            for (int o = 0; o < 4; ++o) den += __expf(lg4[o] - gm);
            const float pg = 1.0f / den;
            int i1 = 0, i2 = 1; float v1 = -3.0e38f, v2 = -3.0e38f;
#pragma unroll
            for (int o = 0; o < 8; ++o) { const float x = lr[4 + gs * 8 + o] * rt + rbias[4 + gs * 8 + o];
                if (x > v1) { v2 = v1; i2 = i1; v1 = x; i1 = o; } else if (x > v2) { v2 = x; i2 = o; } }
            const float e2 = __expf(v2 - v1), w1 = pg / (1.0f + e2), w2 = pg * e2 / (1.0f + e2);
            const int tt = F.wave * 16 + lane, ea = gs * 8 + i1, eb = gs * 8 + i2;
            te[tt * 2] = ea; te[tt * 2 + 1] = eb; tw[tt * 2] = w1; tw[tt * 2 + 1] = w2;
            tr[tt * 2] = (int)__hip_atomic_fetch_add(&hist[ea], 1u, __ATOMIC_RELAXED, __HIP_MEMORY_SCOPE_WORKGROUP); tr[tt * 2 + 1] = (int)__hip_atomic_fetch_add(&hist[eb], 1u, __ATOMIC_RELAXED, __HIP_MEMORY_SCOPE_WORKGROUP);
        }
        __syncthreads();
        if (F.tid < 32) base[F.tid] = __hip_atomic_fetch_add(cnt + F.tid * 64, hist[F.tid], __ATOMIC_RELAXED, __HIP_MEMORY_SCOPE_AGENT);
        __syncthreads();
        if (F.tid < 256) { const int e = te[F.tid]; const int pos = (int)base[e] + tr[F.tid]; const int a = chunk * 256 + F.tid;
            list[e * LISTCAP + pos] = a; gwt[e * LISTCAP + pos] = tw[F.tid]; }
        __syncthreads();
    }
}

struct CombIn { v2u h[4]; unsigned a[4], b[4]; };
__device__ __forceinline__ void comb_load(CombIn& c, const bf16* H, const unsigned char* Y, int t, int lane) {
#pragma unroll
    for (int j = 0; j < 4; ++j) { c.h[j] = ((const v2u*)(H + (size_t)t * D))[lane + 64 * j]; c.a[j] = ((const unsigned*)(Y + (size_t)(2 * t) * D))[lane + 64 * j]; c.b[j] = ((const unsigned*)(Y + (size_t)(2 * t + 1) * D))[lane + 64 * j]; }
}
template <bool FINAL> __device__ __forceinline__ void comb_row(const CombIn& c, const f32x4 (&gg)[4], bf16* H, float* OUT, float* RROW, int t, int lane, const bool dry) {
    unsigned char* A8 = (unsigned char*)RROW - WS_RROW + WS_XN;
    f32x4 v[4]; float s = 0.f;
#pragma unroll
    for (int j = 0; j < 4; ++j) { const v2u h = c.h[j]; const f32x2 a0 = __builtin_amdgcn_cvt_pk_f32_fp8((int)c.a[j], false), a1 = __builtin_amdgcn_cvt_pk_f32_fp8((int)c.a[j], true), b0 = __builtin_amdgcn_cvt_pk_f32_fp8((int)c.b[j], false), b1 = __builtin_amdgcn_cvt_pk_f32_fp8((int)c.b[j], true);
        v[j].x = bflo(h.x) + (a0.x + b0.x) * (1.0f / Y_SCALE); v[j].y = bfhi(h.x) + (a0.y + b0.y) * (1.0f / Y_SCALE); v[j].z = bflo(h.y) + (a1.x + b1.x) * (1.0f / Y_SCALE); v[j].w = bfhi(h.y) + (a1.y + b1.y) * (1.0f / Y_SCALE);
        s += (v[j].x * v[j].x + v[j].y * v[j].y) + (v[j].z * v[j].z + v[j].w * v[j].w); }
    const float r = 1.0f / sqrtf(wave_sum(s) * (1.0f / D) + EPS);
    if (dry) { asm volatile("" :: "v"(v[0].x * r), "v"(v[1].y), "v"(v[2].z), "v"(v[3].w)); }
    else if (FINAL) {
        f32x4* orow = (f32x4*)(OUT + (size_t)t * D) + lane;
#pragma unroll
        for (int j = 0; j < 4; ++j) orow[64 * j] = v[j] * r * gg[j];
    } else {
        v2u* hr = (v2u*)(H + (size_t)t * D) + lane; float mx = 0.f;
#pragma unroll
        for (int j = 0; j < 4; ++j) { v2u hw; hw.x = pg8::cvt_pk_bf16(v[j].x, v[j].y); hw.y = pg8::cvt_pk_bf16(v[j].z, v[j].w); hr[64 * j] = hw;
            mx = fmaxf(fmaxf(mx, fmaxf(fabsf(v[j].x), fabsf(v[j].y))), fmaxf(fabsf(v[j].z), fabsf(v[j].w))); }
        mx = wave_max(mx); mx = mx > 0.f ? mx : 1.0f;
        { unsigned* q8 = (unsigned*)(A8 + (size_t)t * D) + lane; const float inv = 127.0f / mx;
#pragma unroll
          for (int j = 0; j < 4; ++j) q8[64 * j] = pack4_i8(v[j], inv); }
        if (lane == 0) RROW[t] = r * mx * (1.0f / 127.0f);
    }
}
template <bool FINAL> __device__ __forceinline__ void phase_combine(Frame& F, const float* g, const bool dry = false) {
    bf16* H = (bf16*)(F.ws + WS_H); float* OUT = F.p.out; const unsigned char* Y = F.ws + WS_B; float* RROW = (float*)(F.ws + WS_RROW);
    const int gw = F.wg * NWAVES + F.wave, NGW = F.nwg * NWAVES, lane = F.lane;
    f32x4 gg[4];
#pragma unroll
    for (int j = 0; j < 4; ++j) gg[j] = ((const f32x4*)g)[lane + 64 * j];
    if (gw >= T) return;
    CombIn c0, c1;
    comb_load(c0, H, Y, gw, lane); comb_load(c1, H, Y, gw + NGW < T ? gw + NGW : gw, lane);
    auto pair = [&](const int t) __attribute__((always_inline)) {
        const int t1 = t + NGW, t2 = t + 2 * NGW, t3 = t + 3 * NGW;
        comb_row<FINAL>(c0, gg, H, OUT, RROW, t, lane, dry);
        comb_load(c0, H, Y, t2 < T ? t2 : t, lane);
        if (t1 < T) comb_row<FINAL>(c1, gg, H, OUT, RROW, t1, lane, dry);
        comb_load(c1, H, Y, t3 < T ? t3 : t, lane);
    };
    pair(gw);
    for (int t = gw + 2 * NGW; t < T; t += 2 * NGW) pair(t);
}

__device__ __forceinline__ unsigned sgu_off(int r, int ch) { return (unsigned)(r * 512 + 16 * (ch ^ (2 * ((r & 3) | (((r >> 3) & 1) << 2))))); }
__device__ __forceinline__ void phase_sgu(Frame& F, const bool dry = false) {
    LAS unsigned char* vs = F.lds; LAS float* rs = (LAS float*)(F.lds + 65536);
    bf16* U = (bf16*)(F.ws + WS_A); const bf16* V = (const bf16*)(F.ws + WS_B); const float* SSQ = (const float*)(F.ws + WS_SSQ);
    const bf16* WST = (const bf16*)(F.ws + WS_WST); const float* vg = F.p.in[I_GVG]; const float* bs = F.p.in[I_GBS];
    const int lane = F.lane, fr = lane & 15, fq = lane >> 4, wm = F.wave >> 2, wn = F.wave & 3;
    const unsigned vsb = (unsigned)(size_t)vs;
    const int q = (lane & 15) >> 2, pp = lane & 3;
    const int srow = F.tid >> 2, spc = (F.tid & 3) * 2;
    int hcur = -1;
    bf16x8 wsf[4][4];
    LAS float* vgl = (LAS float*)(F.lds + 65536 + 1024); LAS float* bsl = vgl + 256;
#pragma unroll
    for (int a = 0; a < 4; ++a)
#pragma unroll
        for (int k = 0; k < 4; ++k) wsf[a][k] = (bf16x8){0, 0, 0, 0, 0, 0, 0, 0};
    const int nunits = (T / GB) * GH;
    int par = 0;
    if (F.wg < nunits) {
        const f32x4* sp = (const f32x4*)(SSQ + (size_t)((F.wg / GH) * GB + srow) * 32) + spc; const f32x4 x0 = sp[0], x1 = sp[1];
        float sm = ((x0.x + x0.y) + (x0.z + x0.w)) + ((x1.x + x1.y) + (x1.z + x1.w)); sm += __shfl_xor(sm, 1); sm += __shfl_xor(sm, 2);
        if ((F.tid & 3) == 0) rs[srow] = 1.0f / sqrtf(sm * (1.0f / GI) + EPS);
    }
    for (int unit = F.wg; unit < nunits; unit += F.nwg) {
        const int nb = unit / GH, h = unit % GH, un = unit + F.nwg;
        if (h != hcur) { hcur = h;
#pragma unroll
            for (int a = 0; a < 4; ++a) { const int it = (a < 2) ? (2 * wm + a) : (4 + 2 * wm + (a - 2));
#pragma unroll
                for (int k = 0; k < 4; ++k) if (a >= 2 || k < 2) wsf[a][k] = *(const bf16x8*)(WST + ((size_t)h * GB + it * 16 + fr) * GB + k * 32 + 8 * fq); }
            __syncthreads();
            if (F.tid < 256) vgl[F.tid] = vg[h * GHD + F.tid]; else if (F.tid < 384) bsl[F.tid - 256] = bs[h * GB + (F.tid - 256)]; }
        __syncthreads();
        const LAS float* rsc = rs + par * 128;
        f32x4 sq0 = (f32x4){0.f, 0.f, 0.f, 0.f}, sq1 = sq0;
        if (un < nunits) { const f32x4* sp = (const f32x4*)(SSQ + (size_t)((un / GH) * GB + srow) * 32) + spc; sq0 = sp[0]; sq1 = sp[1]; }
        {
            v4u xv[8];
#pragma unroll
            for (int i8 = 0; i8 < 8; ++i8) { const int p = F.tid + 512 * i8, j = p >> 5, ch = p & 31; xv[i8] = *(const v4u*)(V + (size_t)(nb * GB + j) * GI + h * GHD + ch * 8); }
            asm volatile("" : "+v"(xv[0].x), "+v"(xv[1].x), "+v"(xv[2].x), "+v"(xv[3].x), "+v"(xv[4].x), "+v"(xv[5].x), "+v"(xv[6].x), "+v"(xv[7].x));
#pragma unroll
            for (int i8 = 0; i8 < 8; ++i8) { const int p = F.tid + 512 * i8, j = p >> 5, ch = p & 31; const float r = rsc[j]; const v4u x = xv[i8];
                v4u o; o.x = pg8::cvt_pk_bf16(bflo(x.x) * r, bfhi(x.x) * r); o.y = pg8::cvt_pk_bf16(bflo(x.y) * r, bfhi(x.y) * r); o.z = pg8::cvt_pk_bf16(bflo(x.z) * r, bfhi(x.z) * r); o.w = pg8::cvt_pk_bf16(bflo(x.w) * r, bfhi(x.w) * r);
                *(LAS v4u*)(vs + sgu_off(j, ch)) = o; }
        }
        float smn = ((sq0.x + sq0.y) + (sq0.z + sq0.w)) + ((sq1.x + sq1.y) + (sq1.z + sq1.w));
        v4u uu[4][2];
#pragma unroll
        for (int a = 0; a < 4; ++a) { const int it = (a < 2) ? (2 * wm + a) : (4 + 2 * wm + (a - 2));
#pragma unroll
            for (int cp = 0; cp < 2; ++cp) uu[a][cp] = *(const v4u*)(U + (size_t)(nb * GB + it * 16 + fr) * GI + h * GHD + 64 * wn + 32 * cp + 8 * fq); }
        __syncthreads();
        f32x4 acc[4][4];
#pragma unroll
        for (int a = 0; a < 4; ++a)
#pragma unroll
            for (int c = 0; c < 4; ++c) acc[a][c] = (f32x4){0.f, 0.f, 0.f, 0.f};
#pragma unroll
        for (int ks = 0; ks < 4; ++ks) {
            typedef short s16x4 __attribute__((ext_vector_type(4))); s16x4 t0, t1, t2, t3, t4, t5, t6, t7;
            const unsigned r0 = vsb + sgu_off(32 * ks + 8 * fq + q, 8 * wn + pp), r1 = vsb + sgu_off(32 * ks + 8 * fq + 4 + q, 8 * wn + pp);
            const unsigned r2 = vsb + sgu_off(32 * ks + 8 * fq + q, 8 * wn + 4 + pp), r3 = vsb + sgu_off(32 * ks + 8 * fq + 4 + q, 8 * wn + 4 + pp);
            asm volatile("ds_read_b64_tr_b16 %0, %8\n\tds_read_b64_tr_b16 %1, %9\n\tds_read_b64_tr_b16 %2, %8 offset:8\n\tds_read_b64_tr_b16 %3, %9 offset:8\n\t"
                         "ds_read_b64_tr_b16 %4, %10\n\tds_read_b64_tr_b16 %5, %11\n\tds_read_b64_tr_b16 %6, %10 offset:8\n\tds_read_b64_tr_b16 %7, %11 offset:8\n\ts_waitcnt lgkmcnt(0)"
                         : "=&v"(t0), "=&v"(t1), "=&v"(t2), "=&v"(t3), "=&v"(t4), "=&v"(t5), "=&v"(t6), "=&v"(t7) : "v"(r0), "v"(r1), "v"(r2), "v"(r3) : "memory");
            bf16x8 vf[4];
            vf[0] = (bf16x8){t0[0], t0[1], t0[2], t0[3], t1[0], t1[1], t1[2], t1[3]}; vf[1] = (bf16x8){t2[0], t2[1], t2[2], t2[3], t3[0], t3[1], t3[2], t3[3]};
            vf[2] = (bf16x8){t4[0], t4[1], t4[2], t4[3], t5[0], t5[1], t5[2], t5[3]}; vf[3] = (bf16x8){t6[0], t6[1], t6[2], t6[3], t7[0], t7[1], t7[2], t7[3]};
            __builtin_amdgcn_sched_barrier(0);
#pragma unroll
            for (int a = 0; a < 4; ++a) { if (a < 2 && ks >= 2) continue;
#pragma unroll
                for (int c = 0; c < 4; ++c) acc[a][c] = __builtin_amdgcn_mfma_f32_16x16x32_bf16(vf[c], wsf[a][ks], acc[a][c], 0, 0, 0); }
        }
#pragma unroll
        for (int cp = 0; cp < 2; ++cp) { const int c0 = h * GHD + 64 * wn + 32 * cp + 8 * fq; const f32x4 g0 = *(const LAS f32x4*)(vgl + 64 * wn + 32 * cp + 8 * fq), g1 = *(const LAS f32x4*)(vgl + 64 * wn + 32 * cp + 8 * fq + 4);
#pragma unroll
            for (int a = 0; a < 4; ++a) { const int it = (a < 2) ? (2 * wm + a) : (4 + 2 * wm + (a - 2)); const int i = it * 16 + fr; const float bsi = bsl[i];
                const v4u x = uu[a][cp];
                f32x4 u0 = (f32x4){bflo(x.x), bfhi(x.x), bflo(x.y), bfhi(x.y)}, u1 = (f32x4){bflo(x.z), bfhi(x.z), bflo(x.w), bfhi(x.w)};
                u0 = u0 * (g0 * acc[a][2 * cp] + bsi); u1 = u1 * (g1 * acc[a][2 * cp + 1] + bsi);
                const v4u pk = pg8::pack8(u0, u1); if (dry) { asm volatile("" :: "v"(pk.x), "v"(pk.y), "v"(pk.z), "v"(pk.w)); } else *(v4u*)(U + (size_t)(nb * GB + i) * GI + c0) = pk; } }
        { smn += __shfl_xor(smn, 1); smn += __shfl_xor(smn, 2);
          if ((F.tid & 3) == 0) rs[(par ^ 1) * 128 + srow] = 1.0f / sqrtf(smn * (1.0f / GI) + EPS); }
        par ^= 1;
    }
}

namespace pg8 {
constexpr int BM = 256, BK = 64, HALF = 128, HTB = HALF * BK * 2, STAGE_BYTES = 8 * HTB, NXCD = 8, WGM = 8;
__device__ __forceinline__ int lds_byte(int r, int c) { const int st = (r >> 4) * 2 + (c >> 5), rr = r & 15, cc = c & 31, ob = rr * 64 + cc * 2; return st * 1024 + (ob ^ (((ob >> 9) & 1) << 5)); }
__device__ __forceinline__ void stage_rc(int b, int& R, int& C) { const int st = b / 1024, sb = b % 1024, swz = sb ^ (((sb >> 9) & 1) << 5); R = (st >> 1) * 16 + swz / 64; C = (st & 1) * 32 + (swz % 64) / 2; }
__device__ __forceinline__ int perm32(int rho) { const int n = rho >> 4, i = rho & 15; return 8 * (i >> 2) + 4 * n + (i & 3); }

struct Unit { int pm, pn, e, rb, nvalid; };

struct DenseOrder {
    static constexpr bool GATHER = false;
    const char* A; const char* Bt; int K, nM, nN, nwg, G, c;
    __device__ __forceinline__ void init(const void* A_, const void* Bt_, int M, int N, int K_, int G_, int c_) { A = (const char*)A_; Bt = (const char*)Bt_; K = K_; nM = M / BM; nN = N / BM; nwg = nM * nN; G = G_; c = c_; }
    __device__ __forceinline__ bool next(int i, Unit& u) const {
        const long L = (long)i * G + c; if (L >= nwg) return false;
        int wgid = (int)L; { const int q = nwg / NXCD, r = nwg % NXCD, xcd = wgid % NXCD, off = wgid / NXCD; wgid = (xcd < r ? xcd * (q + 1) : r * (q + 1) + (xcd - r) * q) + off; }
        const int nig = WGM * nN, gid = wgid / nig, fm = gid * WGM, gsz = (nM - fm) < WGM ? (nM - fm) : WGM;
        u.pm = fm + ((wgid % nig) % gsz); u.pn = (wgid % nig) / gsz; u.e = 0; u.rb = 0; u.nvalid = 256; return true;
    }
    __device__ __forceinline__ const char* a_base(const Unit& u) const { return A + (size_t)u.pm * BM * K * 2; }
    __device__ __forceinline__ const char* b_base(const Unit& u) const { return Bt + (size_t)u.pn * BM * K * 2; }
    __device__ __forceinline__ const char* a_origin() const { return A; }
    __device__ __forceinline__ void a_offs(const Unit&, int, int, unsigned (&)[2][2]) const {}
    __device__ __forceinline__ void a_offs_load(const Unit&, int, unsigned (&)[2][2]) const {}
    __device__ __forceinline__ void a_offs_finish(const Unit&, int, int, const unsigned (&)[2][2], unsigned (&)[2][2]) const {}
};
struct DenseOrderG : DenseOrder {
    static constexpr bool GATHER = true;
    __device__ __forceinline__ void a_offs_load(const Unit& u, int R0, unsigned (&raw)[2][2]) const {
#pragma unroll
        for (int h = 0; h < 2; ++h)
#pragma unroll
            for (int i = 0; i < 2; ++i) raw[h][i] = (unsigned)(u.pm * 256 + h * 128 + i * 64 + R0); }
    __device__ __forceinline__ void a_offs_finish(const Unit&, int, int C2, const unsigned (&raw)[2][2], unsigned (&o)[2][2]) const {
#pragma unroll
        for (int h = 0; h < 2; ++h)
#pragma unroll
            for (int i = 0; i < 2; ++i) o[h][i] = raw[h][i] * (unsigned)(K * 2) + (unsigned)C2; }
    __device__ __forceinline__ void a_offs(const Unit& u, int R0, int C2, unsigned (&o)[2][2]) const { unsigned raw[2][2]; a_offs_load(u, R0, raw); a_offs_finish(u, R0, C2, raw, o); }
};
template <bool LISTED> struct MoeOrder {
    static constexpr bool GATHER = true;
    const char* A; const char* Bt; const int* list; int K, G, c; LAS unsigned* tab;
    __device__ __forceinline__ void init(const void* A_, const void* Bt_, const int* list_, const unsigned* cnt, int K_, int G_, int c_, int lane, int wave, LAS unsigned* tab_) {
        A = (const char*)A_; Bt = (const char*)Bt_; list = list_; K = K_; G = G_; c = c_; tab = tab_;
        if (wave == 0) {
            const unsigned cntv = lane < 32 ? __hip_atomic_load(cnt + lane * 64, __ATOMIC_RELAXED, __HIP_MEMORY_SCOPE_AGENT) : 0u;
            unsigned inc = (cntv + 255u) >> 8;
#pragma unroll
            for (int o = 1; o < 64; o <<= 1) { const unsigned t = __shfl_up(inc, o); if (lane >= o) inc += t; }
            unsigned pbv = inc - ((cntv + 255u) >> 8);
            if (lane > 32) pbv = 0xffffffffu;
            tab[lane] = pbv; if (lane < 32) tab[64 + lane] = cntv;
        }
        __syncthreads();
    }
    __device__ __forceinline__ bool next(int i, Unit& u) const {
        const int tot = (int)tab[32] * 4;
        const int L = i * G + (c & 7) * (G >> 3) + (c >> 3); if (L >= tot) return false;
        const int b = L >> 2; u.pm = b; u.pn = L & 3;
        int ln_ = threadIdx.x & 63; asm volatile("" : "+v"(ln_));
        const unsigned pbv = tab[ln_];
        const int e = __builtin_popcountll(__ballot((int)(pbv <= (unsigned)b))) - 1;
        u.e = e; u.rb = b - (int)__builtin_amdgcn_readlane(pbv, e);
        const int left = (int)tab[64 + e] - u.rb * 256; u.nvalid = left < 256 ? left : 256; return true;
    }
    __device__ __forceinline__ const char* a_base(const Unit& u) const { return A + (size_t)u.pm * BM * K * 2; }
    __device__ __forceinline__ const char* b_base(const Unit& u) const { return Bt + ((size_t)u.e * D + (size_t)u.pn * BM) * K * 2; }
    __device__ __forceinline__ const char* a_origin() const { return A; }
    __device__ __forceinline__ void a_offs_load(const Unit& u, int R0, unsigned (&raw)[2][2]) const {
#pragma unroll
        for (int h = 0; h < 2; ++h)
#pragma unroll
            for (int i = 0; i < 2; ++i) { const int idx = h * 128 + i * 64 + R0;
                if constexpr (LISTED) raw[h][i] = (unsigned)list[u.e * LISTCAP + u.rb * 256 + (idx < u.nvalid ? idx : 0)];
                else raw[h][i] = (unsigned)(u.pm * 256 + idx); }
    }
    __device__ __forceinline__ void a_offs_finish(const Unit& u, int R0, int C2, const unsigned (&raw)[2][2], unsigned (&o)[2][2]) const {
#pragma unroll
        for (int h = 0; h < 2; ++h)
#pragma unroll
            for (int i = 0; i < 2; ++i) { const int idx = h * 128 + i * 64 + R0;
                if constexpr (LISTED) o[h][i] = (idx < u.nvalid ? (raw[h][i] >> 1) : 0u) * (unsigned)(K * 2) + (unsigned)C2;
                else o[h][i] = raw[h][i] * (unsigned)(K * 2) + (unsigned)C2; }
    }
    __device__ __forceinline__ void a_offs(const Unit& u, int R0, int C2, unsigned (&o)[2][2]) const { unsigned raw[2][2]; a_offs_load(u, R0, raw); a_offs_finish(u, R0, C2, raw, o); }
};

struct FEpiGlu {
    static constexpr bool PERM = true, PERM16 = false; bf16* Z; const float* bias; const float* rrow; const unsigned* wmax;
    struct Row { float r; };
    __device__ __forceinline__ void row_load(const Unit& u, int tid, Row& rw) const { rw.r = rrow[u.pm * BM + (tid & 255)] * (wmax8(wmax + u.pn * 128) * (1.0f / 127.0f)); }
    __device__ __forceinline__ void row_store(LAS unsigned char* buf, int tid, const Row& rw) const { ((LAS float*)buf)[tid & 255] = rw.r; }
    __device__ __forceinline__ void stage(LAS float* lb, int tid) const { for (int i = tid; i < 2048 / 4; i += NTHREADS) ((LAS f32x4*)lb)[i] = ((const f32x4*)bias)[i]; }
    __device__ __forceinline__ void operator()(const f32x4 (&acc)[2][2][4][2], const Unit& u, int wr, int wc, int fr, int fq, const LAS unsigned char* rowbuf, const LAS float* lb) const {
        const int row0 = u.pm * BM + wr * 64 + fr, col0 = u.pn * 128 + wc * 32 + 8 * fq; const LAS float* rl = (const LAS float*)rowbuf + wr * 64 + fr;
        const f32x4 ba0 = *(const LAS f32x4*)(lb + col0), ba1 = *(const LAS f32x4*)(lb + col0 + 4), bg0 = *(const LAS f32x4*)(lb + 1024 + col0), bg1 = *(const LAS f32x4*)(lb + 1024 + col0 + 4);
#pragma unroll
        for (int ai = 0; ai < 2; ++ai)
#pragma unroll
            for (int m = 0; m < 4; ++m) { bf16* rowp = Z + (size_t)(row0 + ai * HALF + m * 16) * D + col0; const float rr = rl[ai * HALF + m * 16];
                f32x4 s0 = acc[ai][1][m][0] * rr + bg0, s1 = acc[ai][1][m][1] * rr + bg1; act_poly8<false>(s0, s1); const f32x4 z0 = (acc[ai][0][m][0] * rr + ba0) * s0, z1 = (acc[ai][0][m][1] * rr + ba1) * s1;
                *(v4u*)rowp = pack8(z0, z1); }
    }
};
struct FEpiBf16S {
    static constexpr bool PERM = true, PERM16 = false; bf16* O; const float* bias; const float* rrow; const unsigned* wmax;
    struct Row { float r; };
    __device__ __forceinline__ void row_load(const Unit& u, int tid, Row& rw) const { rw.r = rrow[u.pm * BM + (tid & 255)] * (wmax8(wmax + u.pn * 128) * (1.0f / 127.0f)); }
    __device__ __forceinline__ void row_store(LAS unsigned char* buf, int tid, const Row& rw) const { ((LAS float*)buf)[tid & 255] = rw.r; }
    __device__ __forceinline__ void stage(LAS float* lb, int tid) const { for (int i = tid; i < 1024 / 4; i += NTHREADS) ((LAS f32x4*)lb)[i] = ((const f32x4*)bias)[i]; }
    __device__ __forceinline__ void operator()(const f32x4 (&acc)[2][2][4][2], const Unit& u, int wr, int wc, int fr, int fq, const LAS unsigned char* rowbuf, const LAS float* lb) const {
        const int row0 = u.pm * BM + wr * 64 + fr, col0 = u.pn * BM + wc * 32 + 8 * fq; const LAS float* rl = (const LAS float*)rowbuf + wr * 64 + fr;
        f32x4 bv[2][2];
#pragma unroll
        for (int bj = 0; bj < 2; ++bj)
#pragma unroll
            for (int n = 0; n < 2; ++n) bv[bj][n] = *(const LAS f32x4*)(lb + col0 + bj * HALF + 4 * n);
#pragma unroll
        for (int ai = 0; ai < 2; ++ai)
#pragma unroll
            for (int m = 0; m < 4; ++m) { bf16* rowp = O + (size_t)(row0 + ai * HALF + m * 16) * D + col0; const float rr = rl[ai * HALF + m * 16];
#pragma unroll
                for (int bj = 0; bj < 2; ++bj) *(v4u*)(rowp + bj * HALF) = pack8(acc[ai][bj][m][0] * rr + bv[bj][0], acc[ai][bj][m][1] * rr + bv[bj][1]); }
    }
};
struct FEpiBf16 {
    static constexpr bool PERM = true, PERM16 = false; bf16* O; const float* bias;
    struct Row {}; __device__ __forceinline__ void row_load(const Unit&, int, Row&) const {} __device__ __forceinline__ void row_store(LAS unsigned char*, int, const Row&) const {}
    __device__ __forceinline__ void stage(LAS float* lb, int tid) const { for (int i = tid; i < 1024 / 4; i += NTHREADS) ((LAS f32x4*)lb)[i] = ((const f32x4*)bias)[i]; }
    __device__ __forceinline__ void operator()(const f32x4 (&acc)[2][2][4][2], const Unit& u, int wr, int wc, int fr, int fq, const LAS unsigned char*, const LAS float* lb) const {
        const int row0 = u.pm * BM + wr * 64 + fr, col0 = u.pn * BM + wc * 32 + 8 * fq;
        f32x4 bv[2][2];
#pragma unroll
        for (int bj = 0; bj < 2; ++bj)
#pragma unroll
            for (int n = 0; n < 2; ++n) bv[bj][n] = *(const LAS f32x4*)(lb + col0 + bj * HALF + 4 * n);
#pragma unroll
        for (int ai = 0; ai < 2; ++ai)
#pragma unroll
            for (int m = 0; m < 4; ++m) { bf16* rowp = O + (size_t)(row0 + ai * HALF + m * 16) * D + col0;
#pragma unroll
                for (int bj = 0; bj < 2; ++bj) *(v4u*)(rowp + bj * HALF) = pack8(acc[ai][bj][m][0] + bv[bj][0], acc[ai][bj][m][1] + bv[bj][1]); }
    }
};
struct FEpiGeluUV {
    static constexpr bool PERM = true, PERM16 = false; bf16* U; bf16* V; float* SSQ; const float* bias; const float* rrow; const unsigned* wmax;
    struct Row { float r; };
    __device__ __forceinline__ void row_load(const Unit& u, int tid, Row& rw) const { rw.r = rrow[u.pm * BM + (tid & 255)] * (wmax8(wmax + u.pn * 128) * (1.0f / 127.0f)); }
    __device__ __forceinline__ void row_store(LAS unsigned char* buf, int tid, const Row& rw) const { ((LAS float*)buf)[tid & 255] = rw.r; }
    __device__ __forceinline__ void stage(LAS float* lb, int tid) const { for (int i = tid; i < 4096 / 4; i += NTHREADS) ((LAS f32x4*)lb)[i] = ((const f32x4*)bias)[i]; }
    __device__ __forceinline__ void operator()(const f32x4 (&acc)[2][2][4][2], const Unit& u, int wr, int wc, int fr, int fq, const LAS unsigned char* rowbuf, const LAS float* lb) const {
        const int row0 = u.pm * BM + wr * 64 + fr; const bool isv = u.pn >= 8; bf16* base = isv ? V : U;
        const int col0 = (u.pn & 7) * BM + wc * 32 + 8 * fq, bcol0 = u.pn * BM + wc * 32 + 8 * fq; const LAS float* rl = (const LAS float*)rowbuf + wr * 64 + fr;
        f32x4 bv[2][2];
#pragma unroll
        for (int bj = 0; bj < 2; ++bj)
#pragma unroll
            for (int n = 0; n < 2; ++n) bv[bj][n] = *(const LAS f32x4*)(lb + bcol0 + bj * HALF + 4 * n);
#pragma unroll
        for (int ai = 0; ai < 2; ++ai)
#pragma unroll
            for (int m = 0; m < 4; ++m) { const int row = row0 + ai * HALF + m * 16; bf16* rowp = base + (size_t)row * GI + col0; f32x2 ss2 = {0.f, 0.f}; const float rr = rl[ai * HALF + m * 16];
#pragma unroll
                for (int bj = 0; bj < 2; ++bj) { f32x4 v0 = acc[ai][bj][m][0] * rr + bv[bj][0], v1 = acc[ai][bj][m][1] * rr + bv[bj][1];
                    act_poly8<true>(v0, v1);
                    if (isv) { const f32x2 a = {v0.x, v0.y}, b = {v0.z, v0.w}, c = {v1.x, v1.y}, d = {v1.z, v1.w}; ss2 = a * a + ss2; ss2 = b * b + ss2; ss2 = c * c + ss2; ss2 = d * d + ss2; }
                    *(v4u*)(rowp + bj * HALF) = pack8(v0, v1); }
                if (isv) { float ss = ss2.x + ss2.y; ss += __shfl_xor(ss, 16); ss += __shfl_xor(ss, 32); if (fq == 0) SSQ[(size_t)row * 32 + (u.pn - 8) * 4 + wc] = ss; } }
    }
};
struct FEpiMoeGU {
    static constexpr bool PERM = true, PERM16 = false; unsigned char* HB;
    struct Row {}; __device__ __forceinline__ void row_load(const Unit&, int, Row&) const {} __device__ __forceinline__ void row_store(LAS unsigned char*, int, const Row&) const {}
    __device__ __forceinline__ void stage(LAS float*, int) const {}
    __device__ __forceinline__ void operator()(const f32x4 (&acc)[2][2][4][2], const Unit& u, int wr, int wc, int fr, int fq, const LAS unsigned char*, const LAS float*) const {
        const int row0 = u.pm * BM + wr * 64 + fr, col0 = u.pn * 128 + wc * 32 + 8 * fq;
#pragma unroll
        for (int ai = 0; ai < 2; ++ai)
#pragma unroll
            for (int m = 0; m < 4; ++m) { unsigned char* rowp = HB + (size_t)(row0 + ai * HALF + m * 16) * DE + col0;
                const f32x4 g0 = acc[ai][0][m][0], g1 = acc[ai][0][m][1];
                f32x4 s0 = g0, s1 = g1; act_poly8<false>(s0, s1); v2u w; w.x = pack4_fp8(g0 * s0 * acc[ai][1][m][0]); w.y = pack4_fp8(g1 * s1 * acc[ai][1][m][1]); *(v2u*)rowp = w; }
    }
};
struct FEpiMoeDown {
    static constexpr bool PERM = true, PERM16 = true;
    unsigned char* Y; const int* list; const float* gw; unsigned char* sink;
    struct Row { int a; float w; bool ok; };
    __device__ __forceinline__ void row_load(const Unit& u, int tid, Row& rw) const { const int r = tid & 255; rw.ok = r < u.nvalid; const int idx = u.e * LISTCAP + u.rb * 256 + (rw.ok ? r : 0);
        rw.a = list[idx]; rw.w = gw[idx]; }
    __device__ __forceinline__ void row_store(LAS unsigned char* buf, int tid, const Row& rw) const { ((LAS int*)buf)[tid & 255] = rw.ok ? rw.a : -1; ((LAS float*)(buf + 1024))[tid & 255] = rw.ok ? rw.w * Y_SCALE : 0.f; }
    __device__ __forceinline__ void stage(LAS float*, int) const {}
    __device__ __forceinline__ void operator()(const f32x4 (&acc)[2][2][4][2], const Unit& u, int wr, int wc, int fr, int fq, const LAS unsigned char* rowbuf, const LAS float*) const {
        const int col0 = u.pn * BM + wc * 64 + 16 * fq; const LAS int* al = (const LAS int*)rowbuf + wr * 64 + fr; const LAS float* wl = (const LAS float*)(rowbuf + 1024) + wr * 64 + fr;
#pragma unroll
        for (int ai = 0; ai < 2; ++ai)
#pragma unroll
            for (int m = 0; m < 4; ++m) { const int a = al[ai * HALF + m * 16]; const float w = wl[ai * HALF + m * 16]; unsigned char* rowp = (a >= 0 ? Y + (size_t)a * D : sink) + col0;
                { v4u o; o.x = pack4_fp8(acc[ai][0][m][0] * w); o.y = pack4_fp8(acc[ai][0][m][1] * w); o.z = pack4_fp8(acc[ai][1][m][0] * w); o.w = pack4_fp8(acc[ai][1][m][1] * w); *(v4u*)rowp = o; }
                asm volatile("" ::: "memory"); }
    }
};

typedef int v8i __attribute__((ext_vector_type(8))); typedef int v4i __attribute__((ext_vector_type(4)));
template <int MODE> struct AccT { typedef f32x4 type; }; template <> struct AccT<2> { typedef v4i type; };
template <class Epi, class Sched, int MODE = 0>
__device__ __forceinline__ void gemm_phase(LAS unsigned char* lds, const Sched& S, const Epi& E) {
    const int tid = threadIdx.x, wid = __builtin_amdgcn_readfirstlane(tid >> 6), lane = tid & 63, wr = wid >> 2, wc = wid & 3, fr = lane & 15, fq = lane >> 4;
    const int K = S.K, nt = K / BK;
    int R0, C0; stage_rc(tid * 16, R0, C0);
    const int Rb0 = Epi::PERM ? ((R0 & ~31) + perm32(R0 & 31)) : R0;
    unsigned voffA[2], voffB[2];
#pragma unroll
    for (int i = 0; i < 2; ++i) { voffA[i] = (unsigned)((R0 + 64 * i) * K + C0) * 2u; voffB[i] = (unsigned)((Rb0 + 64 * i) * K + C0) * 2u; }
    unsigned voffB16[2][2] = {{0u, 0u}, {0u, 0u}};
    if constexpr (Epi::PERM16) {
#pragma unroll
        for (int h = 0; h < 2; ++h)
#pragma unroll
            for (int i = 0; i < 2; ++i) { const int R = R0 + 64 * i; voffB16[h][i] = (unsigned)((64 * (R >> 5) + 16 * ((R >> 2) & 3) + 8 * h + 4 * ((R >> 4) & 1) + (R & 3)) * K + C0) * 2u; } }
    const size_t kstep = (size_t)(BK * 2);
    const size_t hstep = (size_t)HALF * K * 2;
    const unsigned ldsb = (unsigned)__builtin_amdgcn_readfirstlane((int)((unsigned)(size_t)lds + (unsigned)wid * 1024u));
    const int aoff = lds_byte(wr * 64 + fr, fq * 8), boff = lds_byte(wc * 32 + fr, fq * 8);
#define PG8_SA(b, h) (((b) * 2 + (h)) * HTB)
#define PG8_SB(b, h) ((4 + (b) * 2 + (h)) * HTB)
#define PG8_GLDS(sbase, voff32, ldsdst) asm volatile("s_mov_b32 m0, %2\n\ts_nop 0\n\tglobal_load_lds_dwordx4 %0, %1" :: "v"(voff32), "s"(sbase), "s"(ldsdst) : "memory", "m0")
#define PG8_STAGE_B(bufoff, gbase, h) do { if constexpr (Epi::PERM16) { PG8_GLDS((const char*)(gbase), voffB16[h][0], ldsb + (bufoff)); PG8_GLDS((const char*)(gbase), voffB16[h][1], ldsb + (bufoff) + 8192u); } \
        else { PG8_GLDS((const char*)(gbase) + (h) * hstep, voffB[0], ldsb + (bufoff)); PG8_GLDS((const char*)(gbase) + (h) * hstep, voffB[1], ldsb + (bufoff) + 8192u); } } while (0)
#define PG8_STAGE_A(bufoff, dbase, offs, h, kb) do { if constexpr (Sched::GATHER) { PG8_GLDS(S.a_origin() + (kb), offs[h][0], ldsb + (bufoff)); PG8_GLDS(S.a_origin() + (kb), offs[h][1], ldsb + (bufoff) + 8192u); } \
        else { PG8_GLDS((dbase) + (h) * hstep + (kb), voffA[0], ldsb + (bufoff)); PG8_GLDS((dbase) + (h) * hstep + (kb), voffA[1], ldsb + (bufoff) + 8192u); } } while (0)
#define PG8_LDA(dst, b, h) do { _Pragma("unroll") for (int m = 0; m < 4; ++m) { const v4i _lo = *(const LAS v4i*)(lds + PG8_SA(b, h) + aoff + m * 2048), _hi = *(const LAS v4i*)(lds + PG8_SA(b, h) + aoff + m * 2048 + 1024); dst[m] = __builtin_shufflevector(_lo, _hi, 0, 1, 2, 3, 4, 5, 6, 7); } } while (0)
#define PG8_LDB(dst, b, h) do { _Pragma("unroll") for (int n = 0; n < 2; ++n) { const v4i _lo = *(const LAS v4i*)(lds + PG8_SB(b, h) + boff + n * 2048), _hi = *(const LAS v4i*)(lds + PG8_SB(b, h) + boff + n * 2048 + 1024); dst[n] = __builtin_shufflevector(_lo, _hi, 0, 1, 2, 3, 4, 5, 6, 7); } } while (0)
#define PG8_MMA(ai, bj, At, Bt) do { __builtin_amdgcn_s_setprio(1); _Pragma("unroll") for (int m = 0; m < 4; ++m) _Pragma("unroll") for (int n = 0; n < 2; ++n) { \
        if constexpr (MODE == 1) acc[ai][bj][m][n] = __builtin_amdgcn_mfma_scale_f32_16x16x128_f8f6f4(Bt[n], At[m], acc[ai][bj][m][n], 0, 0, 0, 0, 0, 0);     \
        else { const v4i _b0 = __builtin_shufflevector(Bt[n], Bt[n], 0, 1, 2, 3), _b1 = __builtin_shufflevector(Bt[n], Bt[n], 4, 5, 6, 7), _a0 = __builtin_shufflevector(At[m], At[m], 0, 1, 2, 3), _a1 = __builtin_shufflevector(At[m], At[m], 4, 5, 6, 7); \
            if constexpr (MODE == 2) { acc[ai][bj][m][n] = __builtin_amdgcn_mfma_i32_16x16x64_i8(_b0, _a0, acc[ai][bj][m][n], 0, 0, 0); acc[ai][bj][m][n] = __builtin_amdgcn_mfma_i32_16x16x64_i8(_b1, _a1, acc[ai][bj][m][n], 0, 0, 0); } \
            else { acc[ai][bj][m][n] = __builtin_amdgcn_mfma_f32_16x16x32_bf16(__builtin_bit_cast(bf16x8, _b0), __builtin_bit_cast(bf16x8, _a0), acc[ai][bj][m][n], 0, 0, 0); \
                   acc[ai][bj][m][n] = __builtin_amdgcn_mfma_f32_16x16x32_bf16(__builtin_bit_cast(bf16x8, _b1), __builtin_bit_cast(bf16x8, _a1), acc[ai][bj][m][n], 0, 0, 0); } } } __builtin_amdgcn_s_setprio(0); } while (0)
#define PG8_WAIT_V(n) asm volatile("s_waitcnt vmcnt(" #n ")" ::: "memory")
#define PG8_WAIT_L(n) asm volatile("s_waitcnt lgkmcnt(" #n ")" ::: "memory")
#define PG8_BAR __builtin_amdgcn_s_barrier()
#define PG8_SCHED __builtin_amdgcn_sched_barrier(0)
    Unit cur, nxt, nn;
    if (!S.next(0, cur)) return;
    bool has_next = S.next(1, nxt);
    if (!has_next) nxt = cur;
    typedef typename AccT<MODE>::type acc_t;
    acc_t acc[2][2][4][2];
#pragma unroll
    for (int a = 0; a < 2; ++a)
#pragma unroll
        for (int b = 0; b < 2; ++b)
#pragma unroll
            for (int m = 0; m < 4; ++m)
#pragma unroll
                for (int n = 0; n < 2; ++n) acc[a][b][m][n] = (acc_t){0, 0, 0, 0};
    v8i At[4], B0[2], B1[2];
    unsigned offC[2][2] = {{0u, 0u}, {0u, 0u}}, offN[2][2] = {{0u, 0u}, {0u, 0u}};
    if constexpr (Sched::GATHER) { S.a_offs(cur, R0, C0 * 2, offC); S.a_offs(nxt, R0, C0 * 2, offN); }
    const char* cA = S.a_base(cur); const char* cB = S.b_base(cur);
    int ui = 0;
    LAS unsigned char* rowb = lds + EPI_ROW_OFF; LAS float* biasl = (LAS float*)(lds + EPI_BIAS_OFF);
    typename Epi::Row rowd; E.stage(biasl, tid); E.row_load(cur, tid, rowd); E.row_store(rowb, tid, rowd);
    PG8_STAGE_B(PG8_SB(0, 0), cB, 0); PG8_STAGE_B(PG8_SB(0, 1), cB, 1); PG8_STAGE_A(PG8_SA(0, 0), cA, offC, 0, 0); PG8_STAGE_A(PG8_SA(0, 1), cA, offC, 1, 0);
    if (wr == 1) PG8_BAR;
    PG8_WAIT_V(2); PG8_BAR;
    PG8_STAGE_B(PG8_SB(1, 0), cB + kstep, 0); PG8_STAGE_A(PG8_SA(1, 0), cA, offC, 0, kstep); PG8_STAGE_B(PG8_SB(1, 1), cB + kstep, 1);
    PG8_WAIT_V(6); PG8_BAR;
    for (;;) {
        const char* nA = S.a_base(nxt); const char* nB = S.b_base(nxt);
#pragma unroll 1
        for (int t = 0; t < nt; t += 2) {
            const bool last = (t == nt - 2);
            const size_t k1 = (size_t)(t + 1) * kstep;
            const size_t k2 = last ? 0 : (size_t)(t + 2) * kstep, k3 = k2 + kstep;
            const char* a2 = last ? nA : cA; const char* b2 = (last ? nB : cB) + k2; const char* b3 = b2 + kstep;
            PG8_LDB(B0, 0, 0); PG8_LDB(B1, 0, 1); PG8_SCHED; PG8_LDA(At, 0, 0); PG8_STAGE_A(PG8_SA(1, 1), cA, offC, 1, k1);
            if constexpr (Sched::GATHER) { if (last) {
#pragma unroll
                for (int h = 0; h < 2; ++h)
#pragma unroll
                    for (int i = 0; i < 2; ++i) offC[h][i] = offN[h][i]; } }
            PG8_WAIT_V(8); PG8_WAIT_L(0); PG8_BAR; PG8_MMA(0, 0, At, B0); PG8_MMA(0, 1, At, B1); PG8_BAR; PG8_SCHED;
            PG8_LDA(At, 0, 1); PG8_STAGE_B(PG8_SB(0, 0), b2, 0); PG8_STAGE_B(PG8_SB(0, 1), b2, 1); PG8_STAGE_A(PG8_SA(0, 0), a2, offC, 0, k2);
            PG8_WAIT_V(8); PG8_WAIT_L(0); PG8_BAR; PG8_MMA(1, 0, At, B0); PG8_MMA(1, 1, At, B1); PG8_BAR; PG8_SCHED;
            PG8_LDB(B0, 1, 0); PG8_LDB(B1, 1, 1); PG8_SCHED; PG8_LDA(At, 1, 0); PG8_STAGE_A(PG8_SA(0, 1), a2, offC, 1, k2);
            PG8_WAIT_V(8); PG8_WAIT_L(0); PG8_BAR; PG8_MMA(0, 0, At, B0); PG8_MMA(0, 1, At, B1); PG8_BAR; PG8_SCHED;
            PG8_LDA(At, 1, 1); PG8_STAGE_B(PG8_SB(1, 0), b3, 0); PG8_STAGE_B(PG8_SB(1, 1), b3, 1); PG8_STAGE_A(PG8_SA(1, 0), a2, offC, 0, k3);
            PG8_WAIT_V(8); PG8_WAIT_L(0); PG8_BAR; PG8_MMA(1, 0, At, B0); PG8_MMA(1, 1, At, B1); PG8_BAR; PG8_SCHED;
        }
        if (wr == 0) PG8_BAR;
        bool has_nn = false;
        unsigned rawN[2][2] = {{0u, 0u}, {0u, 0u}};
        if (has_next) { E.row_load(nxt, tid, rowd); has_nn = S.next(ui + 2, nn); if (!has_nn) nn = nxt; if constexpr (Sched::GATHER) S.a_offs_load(nn, R0, rawN); }
        { int fr_ = fr, fq_ = fq; asm volatile("" : "+v"(fr_), "+v"(fq_));
          if constexpr (MODE == 2) { f32x4 accf[2][2][4][2];
#pragma unroll
              for (int a = 0; a < 2; ++a)
#pragma unroll
                  for (int b = 0; b < 2; ++b)
#pragma unroll
                      for (int m = 0; m < 4; ++m)
#pragma unroll
                          for (int n = 0; n < 2; ++n) accf[a][b][m][n] = __builtin_convertvector(acc[a][b][m][n], f32x4);
              E(accf, cur, wr, wc, fr_, fq_, rowb + (ui & 1) * 2048, biasl); }
          else E(acc, cur, wr, wc, fr_, fq_, rowb + (ui & 1) * 2048, biasl); }
        if (has_next) E.row_store(rowb + ((ui + 1) & 1) * 2048, tid, rowd);
        if constexpr (Sched::GATHER) { asm volatile("" : "+v"(rawN[0][0]), "+v"(rawN[0][1]), "+v"(rawN[1][0]), "+v"(rawN[1][1]) :: "memory");
            if (has_next) S.a_offs_finish(nn, R0, C0 * 2, rawN, offN); asm volatile("" : "+v"(offN[0][0]), "+v"(offN[0][1]), "+v"(offN[1][0]), "+v"(offN[1][1])); }
        if (!has_next) break;
#pragma unroll
        for (int a = 0; a < 2; ++a)
#pragma unroll
            for (int b = 0; b < 2; ++b)
#pragma unroll
                for (int m = 0; m < 4; ++m)
#pragma unroll
                    for (int n = 0; n < 2; ++n) acc[a][b][m][n] = (acc_t){0, 0, 0, 0};
        cur = nxt; cA = nA; cB = nB; nxt = nn; has_next = has_nn; ++ui;
        if (wr == 1) PG8_BAR;
    }
    PG8_WAIT_V(0);
    PG8_BAR;
#undef PG8_SA
#undef PG8_SB
#undef PG8_GLDS
#undef PG8_STAGE_A
#undef PG8_STAGE_B
#undef PG8_LDA
#undef PG8_LDB
#undef PG8_MMA
#undef PG8_WAIT_V
#undef PG8_WAIT_L
#undef PG8_BAR
#undef PG8_SCHED
}
}

#define XB_TMO      128
#define XB_XCNT(j)  (256  + 64 * (j))
#define XB_XSUB(j)  (1280 + 64 * (j))
#define XB_XGEN(j)  (2304 + 64 * (j))
#define XB_TOP      3328
#define XB_TOPGEN   3392
#define XCD_BAR_WORDS 3456
#define XB_SPIN_CAP (1u << 18)

__device__ __forceinline__ unsigned xb_ld(unsigned* p)              { return __hip_atomic_load(p, __ATOMIC_RELAXED, __HIP_MEMORY_SCOPE_AGENT); }
__device__ __forceinline__ unsigned xb_add(unsigned* p, unsigned v) { return __hip_atomic_fetch_add(p, v, __ATOMIC_RELAXED, __HIP_MEMORY_SCOPE_AGENT); }
__device__ __forceinline__ unsigned xb_xcc_id() { return (unsigned)__builtin_amdgcn_s_getreg((3 << 11) | 20) & 0xFu; }
#define XB_SPIN(cond, bar) do { unsigned _sp = 0; while (cond) { __builtin_amdgcn_s_sleep(1); \
    if ((++_sp & 255u) == 0u) { if (xb_ld(&(bar)[XB_TMO])) break; if (_sp > XB_SPIN_CAP) { atomicAdd(&(bar)[XB_TMO], 1u); break; } } } } while (0)

struct XcdBarrier {
    unsigned* bar; unsigned x;
    volatile LAS unsigned* st;
};

__device__ __forceinline__ XcdBarrier xcd_barrier_post(unsigned* bar, volatile LAS unsigned* st) {
    XcdBarrier b; b.bar = bar; b.x = xb_xcc_id(); b.st = st;
    if (threadIdx.x == 0) (void)xb_add(&bar[XB_XCNT(b.x)], 1u);
    return b;
}
__device__ __forceinline__ void xcd_barrier_complete(unsigned* bar, unsigned x, unsigned& nloc, unsigned& nx) {
    const unsigned G = gridDim.x * gridDim.y * gridDim.z;
    unsigned sum, cnt, mine, sp = 0u;
    for (;;) {
        sum = 0u; cnt = 0u; mine = 0u;
#pragma unroll
        for (unsigned j = 0; j < 16; ++j) { const unsigned c = xb_ld(&bar[XB_XCNT(j)]); sum += c; cnt += (c > 0u) ? 1u : 0u; mine = (j == x) ? c : mine; }
        if (sum == G) break;
        __builtin_amdgcn_s_sleep(1);
        if ((++sp & 255u) == 0u) { if (xb_ld(&bar[XB_TMO])) break; if (sp > XB_SPIN_CAP) { atomicAdd(&bar[XB_TMO], 1u); break; } }
    }
    nloc = mine > 0u ? mine : 1u; nx = cnt > 0u ? cnt : 1u;
}

__device__ __forceinline__ void xcd_barrier(const XcdBarrier& b) {
    asm volatile("s_waitcnt vmcnt(0)" ::: "memory");
    __syncthreads();
    if (threadIdx.x == 0) {
        unsigned* bar = b.bar;
        __builtin_amdgcn_s_waitcnt(0);
        unsigned nloc = b.st[0], nx = b.st[1];
        if (nloc == 0u) { xcd_barrier_complete(bar, b.x, nloc, nx); b.st[0] = nloc; b.st[1] = nx; }
        const unsigned old = xb_add(&bar[XB_XSUB(b.x)], 1u);
        const unsigned gen = old / nloc;
        if (old + 1u == (gen + 1u) * nloc) {
            __builtin_amdgcn_fence(__ATOMIC_RELEASE, "agent");
            asm volatile("s_waitcnt vmcnt(0)" ::: "memory");
            const unsigned og = xb_add(&bar[XB_TOP], 1u);
            const unsigned tg = og / nx;
            if (og + 1u == (tg + 1u) * nx) xb_add(&bar[XB_TOPGEN], 1u);
            else XB_SPIN(xb_ld(&bar[XB_TOPGEN]) == tg, bar);
            __builtin_amdgcn_fence(__ATOMIC_ACQUIRE, "agent");
            xb_add(&bar[XB_XGEN(b.x)], 1u);
            asm volatile("s_waitcnt vmcnt(0)" ::: "memory");
        } else {
            XB_SPIN(xb_ld(&bar[XB_XGEN(b.x)]) == gen, bar);
            __builtin_amdgcn_fence(__ATOMIC_ACQUIRE, "agent");
            asm volatile("s_waitcnt vmcnt(0)" ::: "memory");
        }
    }
    __syncthreads();
}

enum { PH_PRO = 0, PH_PRO2, PH_PW1, PH_CONV, PH_PW2, PH_ROUTE0, PH_MOEGU0, PH_MOEDN0, PH_COMB0, PH_WIN, PH_SGU, PH_WOUT, PH_ROUTE1, PH_MOEGU1, PH_MOEDN1, PH_FINAL, N_PHASES };
constexpr int FULL_MASK = (1 << N_PHASES) - 1;
#ifndef PROBE_BUILD
#define PROBE_BUILD 0
#endif
constexpr int MISC_OFF = RING_BYTES + 320, LDS_BYTES = 155648;

template <int LAYER> __device__ __forceinline__ void moe_gu_phase(Frame& F) {
    pg8::MoeOrder<true> S; S.init(F.ws + WS_XN8, F.ws + WS_WGU, (const int*)(F.ws + WS_LIST), ctl(F) + CW_CNT + LAYER * 32 * 64, D / 2, F.nwg, F.wg, F.lane, F.wave, (LAS unsigned*)(F.lds + RING_BYTES + 1024));
    pg8::FEpiMoeGU E{F.ws + WS_A};
    pg8::gemm_phase<pg8::FEpiMoeGU, pg8::MoeOrder<true>, 1>(F.lds, S, E);
}
template <int LAYER> __device__ __forceinline__ void moe_dn_phase(Frame& F) {
    pg8::MoeOrder<false> S; S.init(F.ws + WS_A, F.ws + WS_WD, (const int*)(F.ws + WS_LIST), ctl(F) + CW_CNT + LAYER * 32 * 64, DE / 2, F.nwg, F.wg, F.lane, F.wave, (LAS unsigned*)(F.lds + RING_BYTES + 1024));
    pg8::FEpiMoeDown E{F.ws + WS_B, (const int*)(F.ws + WS_LIST), (const float*)(F.ws + WS_GWL), F.ws + WS_SINK};
    pg8::gemm_phase<pg8::FEpiMoeDown, pg8::MoeOrder<false>, 1>(F.lds, S, E);
}

template <int PMASK> __global__ void __launch_bounds__(NTHREADS, 2) k_fused(Params p) {
    extern __shared__ __attribute__((aligned(16))) unsigned char lds[];
    Frame F; F.lds = (LAS unsigned char*)lds; F.tid = threadIdx.x; F.lane = F.tid & 63; F.wave = __builtin_amdgcn_readfirstlane(F.tid >> 6);
    F.wg = blockIdx.x; F.nwg = gridDim.x; F.p = p; F.ws = p.ws;
    volatile LAS unsigned* MISC = (volatile LAS unsigned*)(F.lds + MISC_OFF);
    if (F.tid < 32) MISC[F.tid] = 0u;
    __syncthreads();
    const int lo = p.ph_lo, hi = p.ph_hi;
    const bool multi = hi - lo > 1;
    const bool dry = PROBE_BUILD && (p.dry != 0);
    XcdBarrier bar; bar.bar = ctl(F) + CW_BAR; bar.x = 0; bar.st = MISC + 8;
    if (multi) bar = xcd_barrier_post(ctl(F) + CW_BAR, MISC + 8);
#define IN(k) (((PMASK >> (k)) & 1) && lo <= (k) && (k) < hi)
#define SEAM(k) do { if (IN(k) && IN((k) + 1)) xcd_barrier(bar); else __syncthreads(); } while (0)
    unsigned char* ws = F.ws;
    if (IN(PH_PRO)) { phase_prologue(F); } SEAM(PH_PRO);
    if (IN(PH_PRO2)) { phase_prologue2(F); } SEAM(PH_PRO2);
    if (IN(PH_PW1)) { const bool cfirst = (F.wg >> 3) & 1;
        if (cfirst) convert_moe_layer(F, 0);
        pg8::DenseOrderG S; S.init(ws + WS_XN, ws + WS_W1T, T, 2048, D / 2, F.nwg, F.wg);
        pg8::FEpiGlu E{(bf16*)(ws + WS_A), p.in[I_CB1], (const float*)(ws + WS_RROW), (const unsigned*)(ctl(F) + CW_WMAX + WL_W1 * 16)}; pg8::gemm_phase<pg8::FEpiGlu, pg8::DenseOrderG, 2>(F.lds, S, E);
        if (!cfirst) convert_moe_layer(F, 0); } SEAM(PH_PW1);
    if (IN(PH_CONV)) { phase_conv(F); } SEAM(PH_CONV);
    if (IN(PH_PW2)) { pg8::DenseOrderG S; S.init(ws + WS_A + 64 * MiB, ws + WS_W2T, T, D, D / 2, F.nwg, F.wg);
        pg8::FEpiBf16S E{(bf16*)(ws + WS_A), p.in[I_CB2], (const float*)(ws + WS_RROW), (const unsigned*)(ctl(F) + CW_WMAX + WL_W2 * 16)}; pg8::gemm_phase<pg8::FEpiBf16S, pg8::DenseOrderG, 2>(F.lds, S, E); } SEAM(PH_PW2);
    if (IN(PH_ROUTE0)) { phase_route<true>(F, 0, dry ? 2 : 0, p.in[I_X], (const bf16*)(ws + WS_A)); } SEAM(PH_ROUTE0);
    if (IN(PH_MOEGU0)) { moe_gu_phase<0>(F); } SEAM(PH_MOEGU0);
    if (IN(PH_MOEDN0)) { moe_dn_phase<0>(F); } SEAM(PH_MOEDN0);
    if (IN(PH_COMB0)) { if (!PROBE_BUILD || p.dry != 2) { convert_win_i8(F); } if (!PROBE_BUILD || p.dry != 3) phase_combine<false>(F, p.in[I_NMG] + D, dry); } SEAM(PH_COMB0);
    if (IN(PH_WIN)) { const bool cfirst = (F.wg >> 3) & 1;
        if (cfirst) convert_moe_layer(F, 1);
        pg8::DenseOrderG S; S.init(ws + WS_XN, ws + WS_WINT, T, 4096, D / 2, F.nwg, F.wg);
        pg8::FEpiGeluUV E{(bf16*)(ws + WS_A), (bf16*)(ws + WS_B), (float*)(ws + WS_SSQ), p.in[I_GBIN], (const float*)(ws + WS_RROW), (const unsigned*)(ctl(F) + CW_WMAX + WL_WIN * 16)}; pg8::gemm_phase<pg8::FEpiGeluUV, pg8::DenseOrderG, 2>(F.lds, S, E);
        if (!cfirst) convert_moe_layer(F, 1); } SEAM(PH_WIN);
    if (IN(PH_SGU)) { phase_sgu(F, dry); } SEAM(PH_SGU);
    if (IN(PH_WOUT)) { pg8::DenseOrder S; S.init(ws + WS_A, ws + WS_WOUTT, T, D, GI, F.nwg, F.wg); pg8::FEpiBf16 E{(bf16*)(ws + WS_B), p.in[I_GBOUT]}; pg8::gemm_phase(F.lds, S, E); } SEAM(PH_WOUT);
    if (IN(PH_ROUTE1)) { phase_route<false>(F, 1, 1, ws + WS_H, (const bf16*)(ws + WS_B)); } SEAM(PH_ROUTE1);
    if (IN(PH_MOEGU1)) { moe_gu_phase<1>(F); } SEAM(PH_MOEGU1);
    if (IN(PH_MOEDN1)) { moe_dn_phase<1>(F); } SEAM(PH_MOEDN1);
    if (IN(PH_FINAL)) { phase_combine<true>(F, p.in[I_FG], dry); }
#undef IN
#undef SEAM
}

#ifndef REPEAT_PHASE
#define REPEAT_PHASE -1
#endif
template <int PH> static void launch_one(Params p, int dry, hipStream_t stream) {
    static bool attr = false;
    if (!attr) { (void)hipFuncSetAttribute((const void*)k_fused<(1 << PH)>, hipFuncAttributeMaxDynamicSharedMemorySize, LDS_BYTES); attr = true; }
    p.ph_lo = PH; p.ph_hi = PH + 1; p.dry = dry;
    hipLaunchKernelGGL(k_fused<(1 << PH)>, dim3(256), dim3(NTHREADS), LDS_BYTES, stream, p);
}
template <int PH> static void launch_probe(const Params& p, hipStream_t stream) {
    if constexpr (PROBE_BUILD != 0) {
        constexpr bool inplace = (PH == PH_COMB0 || PH == PH_SGU || PH == PH_FINAL || PH == PH_ROUTE0 || PH == PH_ROUTE1);
        if (REPEAT_PHASE == PH) launch_one<PH>(p, inplace ? (PH == PH_COMB0 ? 2 : 1) : 0, stream);
        if (REPEAT_PHASE == 100 + PH && PH == PH_COMB0) launch_one<PH>(p, 3, stream);
        launch_one<PH>(p, 0, stream);
    }
}

extern "C" void kernel_launch(void* const* d_in, const int* in_sizes, int n_in, void* d_out, int out_size, void* d_ws, size_t ws_size, hipStream_t stream) {
    if (n_in != N_IN || out_size != T * D || ws_size < WS_END) { fprintf(stderr, "kernel_launch: unexpected shapes (n_in %d out %d ws %zu)\n", n_in, out_size, ws_size); return; }
    (void)in_sizes;
    Params p{};
    for (int i = 0; i < N_IN; ++i) p.in[i] = (const float*)d_in[i];
    p.out = (float*)d_out; p.ws = (unsigned char*)d_ws;
    unsigned char* ws = (unsigned char*)d_ws;
    (void)hipMemsetAsync(ws + WS_CTL, 0, CTL_ZERO_BYTES, stream);
    static int grid = 0;
    if (!grid) { int dev = 0, cus = 0; if (hipGetDevice(&dev) != hipSuccess || hipDeviceGetAttribute(&cus, hipDeviceAttributeMultiprocessorCount, dev) != hipSuccess || cus <= 0) cus = 256; grid = (cus < 256 ? cus : 256) & ~7; if (grid < 8) grid = 8; }
    if constexpr (PROBE_BUILD == 0) {
        static bool attr = false;
        if (!attr) { if (hipFuncSetAttribute((const void*)k_fused<FULL_MASK>, hipFuncAttributeMaxDynamicSharedMemorySize, LDS_BYTES) != hipSuccess) fprintf(stderr, "kernel_launch: hipFuncSetAttribute failed\n"); attr = true; }
        p.ph_lo = 0; p.ph_hi = N_PHASES; p.dry = 0;
        hipLaunchKernelGGL(k_fused<FULL_MASK>, dim3(grid), dim3(NTHREADS), LDS_BYTES, stream, p);
        return;
    }
    if constexpr (PROBE_BUILD != 0) {
    launch_probe<PH_PRO>(p, stream); launch_probe<PH_PRO2>(p, stream); launch_probe<PH_PW1>(p, stream); launch_probe<PH_CONV>(p, stream); launch_probe<PH_PW2>(p, stream); launch_probe<PH_ROUTE0>(p, stream);
    launch_probe<PH_MOEGU0>(p, stream); launch_probe<PH_MOEDN0>(p, stream); launch_probe<PH_COMB0>(p, stream); launch_probe<PH_WIN>(p, stream); launch_probe<PH_SGU>(p, stream);
    launch_probe<PH_WOUT>(p, stream); launch_probe<PH_ROUTE1>(p, stream); launch_probe<PH_MOEGU1>(p, stream); launch_probe<PH_MOEDN1>(p, stream); launch_probe<PH_FINAL>(p, stream);
    }
}
```

```cpp
#include <hip/hip_runtime.h>
#include <cstdio>
#include <cstdint>

#define GAS __attribute__((address_space(1)))
#define LAS __attribute__((address_space(3)))
typedef unsigned short bf16;
typedef unsigned v4u __attribute__((ext_vector_type(4)));
typedef unsigned v2u __attribute__((ext_vector_type(2)));
typedef float f32x4 __attribute__((ext_vector_type(4)));
typedef float f32x2 __attribute__((ext_vector_type(2)));
typedef short bf16x8 __attribute__((ext_vector_type(8)));

constexpr int BATCH = 8, SEQ = 4096, D = 1024, T = BATCH * SEQ;
constexpr int CONVW = 31, GI = 2048, GH = 8, GHD = 256, GB = 128;
constexpr int NG = 4, EPG = 8, NE = 32, DE = 512;
constexpr int LISTCAP = 32768;
constexpr float EPS = 1e-6f;
constexpr int NTHREADS = 512, NWAVES = 8;
constexpr int RING_BYTES = 131072, EPI_ROW_OFF = 131072 + 2048, EPI_BIAS_OFF = 131072 + 8192;

enum { I_X = 0, I_NMG, I_NFG, I_CW1, I_CB1, I_CDW, I_CDB, I_CLG, I_CLB, I_CW2, I_CB2, I_GWIN, I_GBIN, I_GVG, I_GWS, I_GBS, I_GWOUT, I_GBOUT,
       I_MWG, I_MBG, I_MWE, I_MBE, I_MGATE, I_MUP, I_MDOWN, I_FG, N_IN };

constexpr size_t MiB = 1u << 20;
constexpr size_t WS_CTL = 0, CTL_ZERO_BYTES = 64 * 1024;
constexpr size_t WS_W1T = 2 * MiB;
constexpr size_t WS_W2T = 6 * MiB;
constexpr size_t WS_WINT = 8 * MiB;
constexpr size_t WS_WOUTT = 16 * MiB;
constexpr size_t WS_WRT = 20 * MiB;
constexpr size_t WS_WRB = WS_WRT + 512 * 1024;
constexpr size_t WS_WST = 21 * MiB;
constexpr size_t WS_LIST = 22 * MiB;
constexpr size_t WS_GW = 26 * MiB;
constexpr size_t WS_SSQ = 27 * MiB;
constexpr size_t WS_RROW = 26 * MiB + 512 * 1024;
constexpr size_t WS_SINK = 31 * MiB;
constexpr size_t WS_WGU = 32 * MiB;
constexpr size_t WS_XN8 = 64 * MiB;
constexpr size_t WS_WD = 96 * MiB;
constexpr size_t WS_GWL = 112 * MiB;
constexpr size_t WS_XN = 128 * MiB;
constexpr size_t WS_A = 192 * MiB;
constexpr size_t WS_B = 320 * MiB;
constexpr size_t WS_H = 448 * MiB;
constexpr size_t WS_END = 512 * MiB;
constexpr int CW_CNT = 1024;
constexpr int CW_BAR = 8192;
constexpr int CW_WMAX = 12288;
constexpr int WL_WIN = 0, WL_W1 = 128, WL_W2 = 192;

__device__ __forceinline__ unsigned f2bf(float f) { unsigned u = __builtin_bit_cast(unsigned, f); return (u + 0x7fffu + ((u >> 16) & 1u)) >> 16; }
__device__ __forceinline__ float bf2f(unsigned b) { return __builtin_bit_cast(float, b << 16); }
__device__ __forceinline__ unsigned pk2(float lo, float hi) { return f2bf(lo) | (f2bf(hi) << 16); }
__device__ __forceinline__ float bflo(unsigned w) { return __builtin_bit_cast(float, w << 16); }
__device__ __forceinline__ float bfhi(unsigned w) { return __builtin_bit_cast(float, w & 0xffff0000u); }
__device__ __forceinline__ float dpp_f(float v, const int ctrl_sel) {
    const int x = __builtin_bit_cast(int, v);
    const int r = ctrl_sel == 0 ? __builtin_amdgcn_update_dpp(x, x, 0xB1, 0xf, 0xf, false) : ctrl_sel == 1 ? __builtin_amdgcn_update_dpp(x, x, 0x4E, 0xf, 0xf, false)
                : ctrl_sel == 2 ? __builtin_amdgcn_update_dpp(x, x, 0x141, 0xf, 0xf, false) : __builtin_amdgcn_update_dpp(x, x, 0x140, 0xf, 0xf, false);
    return __builtin_bit_cast(float, r);
}
__device__ __forceinline__ float rl_f(float v, const int lane) { return __builtin_bit_cast(float, __builtin_amdgcn_readlane(__builtin_bit_cast(int, v), lane)); }
__device__ __forceinline__ float wave_sum(float v) {
    v += dpp_f(v, 0); v += dpp_f(v, 1); v += dpp_f(v, 2); v += dpp_f(v, 3);
    return (rl_f(v, 0) + rl_f(v, 16)) + (rl_f(v, 32) + rl_f(v, 48));
}
__device__ __forceinline__ float sigmoidf_(float x) { return 1.0f / (1.0f + __expf(-x)); }
__device__ __forceinline__ float gelu_tanh(float x) { const float u = 1.5957691216f * (x + 0.044715f * x * x * x); return x / (1.0f + __expf(-u)); }

namespace pg8 {
__device__ __forceinline__ unsigned cvt_pk_bf16(float lo, float hi) { unsigned r; asm volatile("v_cvt_pk_bf16_f32 %0, %1, %2" : "=v"(r) : "v"(lo), "v"(hi)); return r; }
__device__ __forceinline__ float fsig(float x) { return __builtin_amdgcn_rcpf(1.0f + __builtin_amdgcn_exp2f(-1.4426950409f * x)); }
__device__ __forceinline__ f32x4 fsig4(f32x4 x) { f32x4 r; r.x = fsig(x.x); r.y = fsig(x.y); r.z = fsig(x.z); r.w = fsig(x.w); return r; }
template <bool GELU> __device__ __forceinline__ void act_poly8(f32x4& v0, f32x4& v1) {
    constexpr float L = GELU ? 4.0f : 6.0f;
    constexpr float c0 = GELU ? 3.9306327547e-01f : 2.4396343897e-01f, c1 = GELU ? -5.7557811454e-02f : -1.5843318026e-02f, c2 = GELU ? 5.8897508891e-03f : 7.6712767852e-04f,
                    c3 = GELU ? -3.1373359558e-04f : -1.9323624743e-05f, c4 = GELU ? 6.5706090729e-06f : 1.8881471062e-07f;
    f32x2 x[4] = {{v0.x, v0.y}, {v0.z, v0.w}, {v1.x, v1.y}, {v1.z, v1.w}}, xc[4], t[4], q[4];
#pragma unroll
    for (int i = 0; i < 4; ++i) { xc[i].x = __builtin_amdgcn_fmed3f(x[i].x, -L, L); xc[i].y = __builtin_amdgcn_fmed3f(x[i].y, -L, L); }
#pragma unroll
    for (int i = 0; i < 4; ++i) t[i] = xc[i] * xc[i];
#pragma unroll
    for (int i = 0; i < 4; ++i) q[i] = t[i] * c4 + c3;
#pragma unroll
    for (int i = 0; i < 4; ++i) q[i] = q[i] * t[i] + c2;
#pragma unroll
    for (int i = 0; i < 4; ++i) q[i] = q[i] * t[i] + c1;
#pragma unroll
    for (int i = 0; i < 4; ++i) q[i] = q[i] * t[i] + c0;
#pragma unroll
    for (int i = 0; i < 4; ++i) { q[i] = q[i] * xc[i] + 0.5f; if (GELU) q[i] = q[i] * x[i]; }
    v0 = (f32x4){q[0].x, q[0].y, q[1].x, q[1].y}; v1 = (f32x4){q[2].x, q[2].y, q[3].x, q[3].y};
}
__device__ __forceinline__ unsigned pack4_fp8(f32x4 a) { unsigned w = 0u; w = (unsigned)__builtin_amdgcn_cvt_pk_fp8_f32(a.x, a.y, (int)w, false); w = (unsigned)__builtin_amdgcn_cvt_pk_fp8_f32(a.z, a.w, (int)w, true); return w; }
__device__ __forceinline__ v4u pack8(f32x4 a, f32x4 b) { v4u w; w.x = cvt_pk_bf16(a.x, a.y); w.y = cvt_pk_bf16(a.z, a.w); w.z = cvt_pk_bf16(b.x, b.y); w.w = cvt_pk_bf16(b.z, b.w); return w; }
}

__device__ __forceinline__ unsigned pack4_i8(f32x4 v, float inv) {
    const f32x4 y = v * inv + 128.0f;
    unsigned w = __builtin_amdgcn_cvt_pk_u8_f32(y.x, 0u, 0u); w = __builtin_amdgcn_cvt_pk_u8_f32(y.y, 1u, w); w = __builtin_amdgcn_cvt_pk_u8_f32(y.z, 2u, w); w = __builtin_amdgcn_cvt_pk_u8_f32(y.w, 3u, w);
    return w ^ 0x80808080u;
}
__device__ __forceinline__ float wave_max(float v) {
    v = fmaxf(v, dpp_f(v, 0)); v = fmaxf(v, dpp_f(v, 1)); v = fmaxf(v, dpp_f(v, 2)); v = fmaxf(v, dpp_f(v, 3));
    return fmaxf(fmaxf(rl_f(v, 0), rl_f(v, 16)), fmaxf(rl_f(v, 32), rl_f(v, 48)));
}

struct Params { const float* in[N_IN]; float* out; unsigned char* ws; int ph_lo, ph_hi, dry, pad; };

struct Frame {
    LAS unsigned char* lds;
    int tid, lane, wave, wg, nwg;
    Params p;
    unsigned char* ws;
};
__device__ __forceinline__ unsigned* ctl(const Frame& F) { return (unsigned*)(F.ws + WS_CTL); }

__device__ __forceinline__ void transpose_item(const float* W, int ldn, int K, bf16* WT, int k0, int n0, int dst_r0, LAS float* scr, int lane, const float* kscale = nullptr) {
#pragma unroll 8
    for (int i = 0; i < 32; ++i) { const int kk = 2 * i + (lane >> 5); float x = W[(size_t)(k0 + kk) * ldn + n0 + (lane & 31)]; if (kscale) x *= kscale[k0 + kk]; scr[kk * 33 + (lane & 31)] = x; }
    asm volatile("s_waitcnt lgkmcnt(0)" ::: "memory");
    const int c = lane & 7;
#pragma unroll
    for (int j = 0; j < 4; ++j) { const int n = (lane >> 3) + 8 * j; const LAS float* s = scr + (8 * c) * 33 + n;
        v4u o; o.x = pk2(s[0 * 33], s[1 * 33]); o.y = pk2(s[2 * 33], s[3 * 33]); o.z = pk2(s[4 * 33], s[5 * 33]); o.w = pk2(s[6 * 33], s[7 * 33]);
        *(v4u*)(WT + (size_t)(dst_r0 + n) * K + k0 + 8 * c) = o; }
    asm volatile("s_waitcnt lgkmcnt(0)" ::: "memory");
}
__device__ __forceinline__ int glu_row(int n, int nh) { return ((n % nh) / 128) * 256 + (n / nh) * 128 + (n % 128); }

__device__ __forceinline__ void transpose_item8(const float* W, int ldn, int K, unsigned char* WT8, int k0, int n0, int dst_r0, float scale, LAS float* scr, int lane) {
#pragma unroll 8
    for (int i = 0; i < 32; ++i) { const int kk = 2 * i + (lane >> 5); scr[kk * 33 + (lane & 31)] = W[(size_t)(k0 + kk) * ldn + n0 + (lane & 31)]; }
    asm volatile("s_waitcnt lgkmcnt(0)" ::: "memory");
    const int c = lane & 7;
#pragma unroll
    for (int j = 0; j < 4; ++j) { const int n = (lane >> 3) + 8 * j; const LAS float* sp = scr + (8 * c) * 33 + n;
        v2u o; o.x = pg8::pack4_fp8((f32x4){sp[0 * 33] * scale, sp[1 * 33] * scale, sp[2 * 33] * scale, sp[3 * 33] * scale}); o.y = pg8::pack4_fp8((f32x4){sp[4 * 33] * scale, sp[5 * 33] * scale, sp[6 * 33] * scale, sp[7 * 33] * scale});
        *(v2u*)(WT8 + (size_t)(dst_r0 + n) * K + k0 + 8 * c) = o; }
    asm volatile("s_waitcnt lgkmcnt(0)" ::: "memory");
}
template <bool KS> __device__ __forceinline__ void transpose_item_i8(const float* W, int ldn, int K, unsigned char* WT8, int k0, int n0, int dst_r0, const float* kscale, float inv, LAS float* scr, int lane) {
    float gl = 1.0f; if constexpr (KS) gl = kscale[k0 + lane];
#pragma unroll 8
    for (int i = 0; i < 32; ++i) { const int kk = 2 * i + (lane >> 5); float w = W[(size_t)(k0 + kk) * ldn + n0 + (lane & 31)];
        if constexpr (KS) { const float g0 = __builtin_bit_cast(float, __builtin_amdgcn_readlane(__builtin_bit_cast(int, gl), 2 * i)), g1 = __builtin_bit_cast(float, __builtin_amdgcn_readlane(__builtin_bit_cast(int, gl), 2 * i + 1)); w *= lane < 32 ? g0 : g1; }
        scr[kk * 33 + (lane & 31)] = w; }
    asm volatile("s_waitcnt lgkmcnt(0)" ::: "memory");
    const int c = lane & 7;
#pragma unroll
    for (int j = 0; j < 4; ++j) { const int n = (lane >> 3) + 8 * j; const LAS float* sp = scr + (8 * c) * 33 + n;
        v2u o; o.x = pack4_i8((f32x4){sp[0 * 33], sp[1 * 33], sp[2 * 33], sp[3 * 33]}, inv); o.y = pack4_i8((f32x4){sp[4 * 33], sp[5 * 33], sp[6 * 33], sp[7 * 33]}, inv);
        *(v2u*)(WT8 + (size_t)(dst_r0 + n) * K + k0 + 8 * c) = o; }
    asm volatile("s_waitcnt lgkmcnt(0)" ::: "memory");
}
template <bool KS> __device__ __forceinline__ void wmax_item(const Frame& F, const float* W, int ldn, int k0, int n0, const float* kscale, int line) {
    float mx = 0.f, gl = 1.0f; if constexpr (KS) gl = kscale[k0 + F.lane];
#pragma unroll
    for (int i = 0; i < 32; ++i) { const int kk = k0 + 2 * i + (F.lane >> 5); float w = W[(size_t)kk * ldn + n0 + (F.lane & 31)];
        if constexpr (KS) { const float g0 = __builtin_bit_cast(float, __builtin_amdgcn_readlane(__builtin_bit_cast(int, gl), 2 * i)), g1 = __builtin_bit_cast(float, __builtin_amdgcn_readlane(__builtin_bit_cast(int, gl), 2 * i + 1)); w *= F.lane < 32 ? g0 : g1; }
        mx = fmaxf(mx, fabsf(w)); }
    mx = wave_max(mx); if (F.lane == 0) atomicMax(ctl(F) + CW_WMAX + line * 16, __float_as_uint(mx));
}
__device__ __forceinline__ float wmax8(const unsigned* lines) { float m = 0.f;
#pragma unroll
    for (int q = 0; q < 8; ++q) m = fmaxf(m, __uint_as_float(lines[q * 16])); return m > 0.f ? m : 1.0f; }
__device__ __forceinline__ float unit_wmax(const Frame& F, int line0) { return wmax8(ctl(F) + CW_WMAX + line0 * 16); }
__device__ __forceinline__ void convert_win_i8(Frame& F, int rank, int nrank) {
    LAS float* scr = (LAS float*)(F.lds + F.wave * 16384);
    const int gw = rank * NWAVES + F.wave, NGW = nrank * NWAVES;
    for (int it = gw; it < 16 * 128; it += NGW) { const int kb = it / 128, nb = it % 128;
        transpose_item_i8<true>(F.p.in[I_GWIN], 4096, D, F.ws + WS_WINT, kb * 64, nb * 32, nb * 32, F.p.in[I_NMG] + D, 127.0f / unit_wmax(F, WL_WIN + (nb >> 3) * 8), scr, F.lane); }
}
constexpr float Y_SCALE = 16.0f;
constexpr float MOE_WSCALE = 1.0f;
__device__ __forceinline__ void convert_moe_layer(Frame& F, int layer, int sel, int rank, int nrank) {
    const float* wg = F.p.in[I_MGATE] + (size_t)layer * NE * D * DE;
    const float* wu = F.p.in[I_MUP] + (size_t)layer * NE * D * DE;
    const float* wd = F.p.in[I_MDOWN] + (size_t)layer * NE * DE * D;
    unsigned char* WGU = F.ws + WS_WGU; unsigned char* WD = F.ws + WS_WD;
    const int w = F.wave, lane = F.lane;
    const int TPE = sel == 0 ? 96 : sel == 1 ? 64 : 32, NT = NE * TPE, RB = sel == 2 ? 64 : 0;
    const unsigned ldsb = (unsigned)(size_t)F.lds;
    auto stage = [&](const int ti, const int b) __attribute__((always_inline)) {
        const int e = ti / TPE, r = RB + ti % TPE; const float* src; int ldn;
        if (r < 64) { const int up = r >> 5, q = r & 31, kb = q >> 1, nb = q & 1; src = (up ? wu : wg) + (size_t)e * D * DE + (size_t)(kb * 64) * DE + nb * 256; ldn = DE; }
        else { const int q = r - 64, kb = q >> 2, nb = q & 3; src = wd + (size_t)e * DE * D + (size_t)(kb * 64) * D + nb * 256; ldn = D; }
        const unsigned voff = (unsigned)((lane ^ w) * 16);
#pragma unroll
        for (int i = 0; i < 8; ++i) { const float* rowp = src + (size_t)(8 * w + i) * ldn; const unsigned m0v = ldsb + (unsigned)(b * 65536 + (8 * w + i) * 1024);
            asm volatile("s_mov_b32 m0, %2\n\ts_nop 0\n\tglobal_load_lds_dwordx4 %0, %1 nt" :: "v"(voff), "s"(rowp), "s"(m0v) : "memory", "m0"); }
    };
    auto emit = [&](const int ti, const int b) __attribute__((always_inline)) {
        const int e = ti / TPE, r = RB + ti % TPE; unsigned char* dst; int pitch, drow;
        if (r < 64) { const int up = r >> 5, q = r & 31, kb = q >> 1, nb = q & 1, n0 = nb * 256 + 32 * w; dst = WGU + (size_t)e * D * D + kb * 64; pitch = D; drow = (n0 / 128) * 256 + up * 128 + (n0 % 128); }
        else { const int q = r - 64, kb = q >> 2, nb = q & 3; dst = WD + (size_t)e * D * DE + kb * 64; pitch = DE; drow = nb * 256 + 32 * w; }
        const int c = lane & 7; const LAS unsigned char* buf = F.lds + b * 65536 + (8 * c) * 1024;
#pragma unroll
        for (int j = 0; j < 4; ++j) { const int nl = (lane >> 3) + 8 * j; const LAS float* sp = (const LAS float*)(buf + (((8 * w + (nl >> 2)) ^ c) * 16) + (nl & 3) * 4);
            v2u o; o.x = pg8::pack4_fp8((f32x4){sp[0] * MOE_WSCALE, sp[256] * MOE_WSCALE, sp[512] * MOE_WSCALE, sp[768] * MOE_WSCALE}); o.y = pg8::pack4_fp8((f32x4){sp[1024] * MOE_WSCALE, sp[1280] * MOE_WSCALE, sp[1536] * MOE_WSCALE, sp[1792] * MOE_WSCALE});
            __builtin_nontemporal_store(o, (v2u*)(dst + (size_t)(drow + nl) * pitch + 8 * c)); }
    };
    __syncthreads();
    int ti = rank, b = 0;
    if (ti < NT) stage(ti, 0);
    for (; ti < NT; ti += nrank, b ^= 1) {
        const int tn = ti + nrank;
        if (tn < NT) { stage(tn, b ^ 1); asm volatile("s_waitcnt vmcnt(8)" ::: "memory"); }
        else asm volatile("s_waitcnt vmcnt(0)" ::: "memory");
        __syncthreads();
        emit(ti, b);
        asm volatile("s_waitcnt lgkmcnt(0)" ::: "memory");
        __syncthreads();
    }
}
__device__ __forceinline__ void rms_row_to_bf16(const float* xrow, const float* g, bf16* orow, int lane) {
    const f32x4* xr = (const f32x4*)xrow + lane; const f32x4* gr = (const f32x4*)g + lane;
    f32x4 v[4]; float s = 0.f;
#pragma unroll
    for (int j = 0; j < 4; ++j) { v[j] = xr[64 * j]; s += (v[j].x * v[j].x + v[j].y * v[j].y) + (v[j].z * v[j].z + v[j].w * v[j].w); }
    const float r = 1.0f / sqrtf(wave_sum(s) * (1.0f / D) + EPS);
    v2u* o8 = (v2u*)orow + lane;
#pragma unroll
    for (int j = 0; j < 4; ++j) { const f32x4 gg = gr[64 * j]; v2u w; w.x = pk2(v[j].x * r * gg.x, v[j].y * r * gg.y); w.y = pk2(v[j].z * r * gg.z, v[j].w * r * gg.w); o8[64 * j] = w; }
}
__device__ __forceinline__ void dense_late_items(Frame& F, int rank, int nrank) {
    LAS float* scr = (LAS float*)(F.lds + F.wave * 16384);
    constexpr int I3 = 16 * 128, I4 = 32 * 32;
    for (int r = rank * NWAVES + F.wave; r < I3 + I4; r += nrank * NWAVES) {
        if (r < I3) { const int kb = r / 128, nb = r % 128; wmax_item<true>(F, F.p.in[I_GWIN], 4096, kb * 64, nb * 32, F.p.in[I_NMG] + D, WL_WIN + (nb >> 3) * 8 + (kb & 7)); }
        else { const int q = r - I3, kb = q / 32, nb = q % 32; transpose_item8(F.p.in[I_GWOUT], D, GI, F.ws + WS_WOUTT, kb * 64, nb * 32, nb * 32, 32.0f, scr, F.lane); }
    }
}
__device__ __forceinline__ void phase_prologue(Frame& F, const bool late_items_here) {
    LAS float* scr = (LAS float*)(F.lds + F.wave * 16384);
    const int gw = F.wg * NWAVES + F.wave, NGW = F.nwg * NWAVES;
    constexpr int I1 = 16 * 64, I2 = 16 * 32;
    if (late_items_here) dense_late_items(F, F.wg, F.nwg);
    for (int it = gw; it < I1 + I2; it += NGW) {
        int r = it;
        if (r < I1) { const int kb = r / 64, nb = r % 64; wmax_item<false>(F, F.p.in[I_CW1], 2048, kb * 64, nb * 32, nullptr, WL_W1 + (glu_row(nb * 32, 1024) >> 8) * 8 + (kb & 7)); continue; } r -= I1;
        { const int kb = r / 32, nb = r % 32; wmax_item<false>(F, F.p.in[I_CW2], D, kb * 64, nb * 32, nullptr, WL_W2 + (nb >> 3) * 8 + (kb & 7)); }
    }
    const int gt = F.wg * NTHREADS + F.tid, NGT = F.nwg * NTHREADS;
    bf16* WRB = (bf16*)(F.ws + WS_WRB);
    for (int i = gt; i < 2 * 48 * D; i += NGT) { const int l = i / (48 * D), o = (i / D) % 48, k = i % D;
        const float gk = F.p.in[I_NFG][l * D + k];
        WRB[i] = (bf16)(o < 4 ? f2bf(gk * F.p.in[I_MWG][((size_t)l * D + k) * NG + o]) : o < 36 ? f2bf(gk * F.p.in[I_MWE][((size_t)l * D + k) * NE + (o - 4)]) : 0u); }
    bf16* WST = (bf16*)(F.ws + WS_WST);
    for (int i = gt; i < GH * GB * GB; i += NGT) { const int ii = (i / GB) % GB, j = i % GB; WST[i] = (bf16)((j / 64 <= ii / 64) ? f2bf(F.p.in[I_GWS][i]) : 0u); }
    unsigned char* XN = F.ws + WS_XN; float* RROW = (float*)(F.ws + WS_RROW);
    {
        const float* X = F.p.in[I_X]; const int lane = F.lane;
        f32x4 gg[4], nx[4];
#pragma unroll
        for (int j = 0; j < 4; ++j) gg[j] = ((const f32x4*)F.p.in[I_NMG])[lane + 64 * j];
        if (gw < T) {
#pragma unroll
            for (int j = 0; j < 4; ++j) nx[j] = __builtin_nontemporal_load((const f32x4*)(X + (size_t)gw * D) + lane + 64 * j); }
        auto xrow = [&](const int m) __attribute__((always_inline)) {
            const int mn = m + NGW < T ? m + NGW : m;
            f32x4 v[4]; float ss = 0.f;
#pragma unroll
            for (int j = 0; j < 4; ++j) { v[j] = nx[j]; ss += (v[j].x * v[j].x + v[j].y * v[j].y) + (v[j].z * v[j].z + v[j].w * v[j].w); }
#pragma unroll
            for (int j = 0; j < 4; ++j) nx[j] = __builtin_nontemporal_load((const f32x4*)(X + (size_t)mn * D) + lane + 64 * j);
            const float r = 1.0f / sqrtf(wave_sum(ss) * (1.0f / D) + EPS);
            float mx = 0.f;
#pragma unroll
            for (int j = 0; j < 4; ++j) { v[j] = v[j] * gg[j]; mx = fmaxf(fmaxf(mx, fmaxf(fabsf(v[j].x), fabsf(v[j].y))), fmaxf(fabsf(v[j].z), fabsf(v[j].w))); }
            mx = wave_max(mx); mx = mx > 0.f ? mx : 1.0f; const float inv = 127.0f / mx;
            unsigned* o8 = (unsigned*)(XN + (size_t)m * D) + lane;
#pragma unroll
            for (int j = 0; j < 4; ++j) o8[64 * j] = pack4_i8(v[j], inv);
            if (lane == 0) RROW[m] = r * mx * (1.0f / 127.0f);
        };
        if (gw < T) xrow(gw);
        for (int m = gw + NGW; m < T; m += NGW) xrow(m);
    }
}

__device__ __forceinline__ void phase_prologue2(Frame& F) {
    LAS float* scr = (LAS float*)(F.lds + F.wave * 16384);
    const int gw = F.wg * NWAVES + F.wave, NGW = F.nwg * NWAVES;
    constexpr int I1 = 16 * 64, I2 = 16 * 32;
    for (int it = gw; it < I1 + I2; it += NGW) {
        int r = it;
        if (r < I1) { const int kb = r / 64, nb = r % 64, dr = glu_row(nb * 32, 1024); transpose_item_i8<false>(F.p.in[I_CW1], 2048, D, F.ws + WS_W1T, kb * 64, nb * 32, dr, nullptr, 127.0f / unit_wmax(F, WL_W1 + (dr >> 8) * 8), scr, F.lane); continue; } r -= I1;
        { const int kb = r / 32, nb = r % 32; transpose_item_i8<false>(F.p.in[I_CW2], D, D, F.ws + WS_W2T, kb * 64, nb * 32, nb * 32, nullptr, 127.0f / unit_wmax(F, WL_W2 + (nb >> 3) * 8), scr, F.lane); }
    }
}

constexpr int CONV_TR = 32;
template <int S> __device__ __forceinline__ void conv_steps(f32x2 (&acc)[32], const f32x2 (&w)[31], const bf16* Z, int t0, int seq0, int c2) {
    if constexpr (S < 32 + 31 - 1) {
        const int row = t0 - 30 + S; const bool ok = row >= seq0;
        unsigned zz = *(const unsigned*)(Z + (size_t)(ok ? row : seq0) * D + c2); zz = ok ? zz : 0u;
        const f32x2 z = (f32x2){bflo(zz), bfhi(zz)};
        constexpr int OLO = S - 30 > 0 ? S - 30 : 0, OHI = S < 31 ? S : 31;
#pragma unroll
        for (int o = OLO; o <= OHI; ++o) acc[o] += w[S - o] * z;
        conv_steps<S + 1>(acc, w, Z, t0, seq0, c2);
    }
}
__device__ __forceinline__ void phase_conv(Frame& F) {
    LAS float* tile = (LAS float*)F.lds;
    const bf16* Z = (const bf16*)(F.ws + WS_A); unsigned char* ZC = F.ws + WS_A + 64 * MiB; float* RROW = (float*)(F.ws + WS_RROW);
    const float* wdw = F.p.in[I_CDW]; const float* bdw = F.p.in[I_CDB]; const float* lg = F.p.in[I_CLG]; const float* lb = F.p.in[I_CLB];
    const int lane = F.lane, c2 = F.tid * 2;
    f32x2 w[CONVW];
#pragma unroll
    for (int k = 0; k < CONVW; ++k) w[k] = *(const f32x2*)(wdw + k * D + c2);
    const f32x2 bias2 = *(const f32x2*)(bdw + c2);
    f32x4 g[4], bb[4];
#pragma unroll
    for (int h = 0; h < 2; ++h) { g[2 * h] = *(const f32x4*)(lg + h * 512 + 8 * lane); g[2 * h + 1] = *(const f32x4*)(lg + h * 512 + 8 * lane + 4);
        bb[2 * h] = *(const f32x4*)(lb + h * 512 + 8 * lane); bb[2 * h + 1] = *(const f32x4*)(lb + h * 512 + 8 * lane + 4); }
    for (int ti = F.wg; ti < T / CONV_TR; ti += F.nwg) {
        const int t0 = ti * CONV_TR, tl0 = t0 % SEQ, seq0 = t0 - tl0;
        f32x2 acc[CONV_TR];
#pragma unroll
        for (int o = 0; o < CONV_TR; ++o) acc[o] = bias2;
        conv_steps<0>(acc, w, Z, t0, seq0, c2);
        __syncthreads();
#pragma unroll
        for (int o = 0; o < CONV_TR; ++o) *(LAS f32x2*)(tile + o * D + c2) = acc[o];
        __syncthreads();
#pragma unroll
        for (int rr = 0; rr < CONV_TR / NWAVES; ++rr) {
            const int r = F.wave * (CONV_TR / NWAVES) + rr;
            f32x4 x[4];
#pragma unroll
            for (int h = 0; h < 2; ++h) { x[2 * h] = *(const LAS f32x4*)(tile + r * D + h * 512 + 8 * lane); x[2 * h + 1] = *(const LAS f32x4*)(tile + r * D + h * 512 + 8 * lane + 4); }
            float sm = 0.f, q = 0.f;
#pragma unroll
            for (int j = 0; j < 4; ++j) { sm += (x[j].x + x[j].y) + (x[j].z + x[j].w); q += (x[j].x * x[j].x + x[j].y * x[j].y) + (x[j].z * x[j].z + x[j].w * x[j].w); }
            sm = wave_sum(sm); q = wave_sum(q);
            const float mu = sm * (1.0f / D), var = fmaxf(q * (1.0f / D) - mu * mu, 0.f);
            const float rstd = 1.0f / sqrtf(var + EPS);
#pragma unroll
            for (int j = 0; j < 4; ++j) { const f32x4 a = g[j] * rstd; x[j] = x[j] * a + (bb[j] - a * mu); }
            { f32x4 s0 = x[0], s1 = x[1], s2 = x[2], s3 = x[3]; pg8::act_poly8<false>(s0, s1); pg8::act_poly8<false>(s2, s3); x[0] = x[0] * s0; x[1] = x[1] * s1; x[2] = x[2] * s2; x[3] = x[3] * s3; }
            float mx = 0.f;
#pragma unroll
            for (int j = 0; j < 4; ++j) mx = fmaxf(fmaxf(mx, fmaxf(fabsf(x[j].x), fabsf(x[j].y))), fmaxf(fabsf(x[j].z), fabsf(x[j].w)));
            mx = wave_max(mx); mx = mx > 0.f ? mx : 1.0f; const float inv = 127.0f / mx;
            { v2u w0, w1; w0.x = pack4_i8(x[0], inv); w0.y = pack4_i8(x[1], inv); w1.x = pack4_i8(x[2], inv); w1.y = pack4_i8(x[3], inv);
              *(v2u*)(ZC + (size_t)(t0 + r) * D + 8 * lane) = w0; *(v2u*)(ZC + (size_t)(t0 + r) * D + 512 + 8 * lane) = w1; }
            if (lane == 0) RROW[t0 + r] = mx * (1.0f / 127.0f);
        }
    }
}

template <bool HIN_F32, bool PRES = false> __device__ __forceinline__ void phase_route(Frame& F, int layer, int cslot, const void* Hin_, const bf16* M) {
    LAS unsigned char* wimg = F.lds; LAS float* lgt = (LAS float*)(F.lds + 98304) + F.wave * (16 * 48);
    LAS unsigned* hist = (LAS unsigned*)(F.lds + 122880); LAS unsigned* base = (LAS unsigned*)(F.lds + 123008);
    LAS int* te = (LAS int*)(F.lds + 123136); LAS int* tr = (LAS int*)(F.lds + 124160); LAS float* tw = (LAS float*)(F.lds + 125184);
    bf16* H = (bf16*)(F.ws + WS_H); unsigned char* XN8 = F.ws + WS_XN8; LAS float* rtok = (LAS float*)(F.lds + 126208) + F.wave * 16;
    const float* Hf = (const float*)Hin_; const bf16* Hb = (const bf16*)Hin_;
    const float* g = F.p.in[I_NFG] + layer * D; const bf16* WRB = (const bf16*)(F.ws + WS_WRB) + (size_t)layer * 48 * D;
    const float* bg = F.p.in[I_MBG] + layer * NG; const float* be = F.p.in[I_MBE] + layer * NE;
    int* list = (int*)(F.ws + WS_LIST); float* gwt = (float*)(F.ws + WS_GWL); unsigned* cnt = ctl(F) + CW_CNT + cslot * 32 * 64;
    const int lane = F.lane, fr = lane & 15, fq = lane >> 4;
#pragma unroll
    for (int i = 0; i < 12; ++i) { const int p = F.tid + 512 * i, o = p >> 7, c = p & 127; *(LAS v4u*)(wimg + o * 2048 + 16 * (c ^ (o & 15))) = *(const v4u*)(WRB + (size_t)o * D + c * 8); }
    LAS float* rbias = (LAS float*)(F.lds + 126720);
    if (F.tid < 4) rbias[F.tid] = bg[F.tid]; else if (F.tid < 36) rbias[F.tid] = be[F.tid - 4];
    f32x4 gg[4];
#pragma unroll
    for (int j = 0; j < 4; ++j) gg[j] = ((const f32x4*)g)[lane + 64 * j];
    for (int chunk = F.wg; chunk < T / 128; chunk += F.nwg) {
        if (F.tid < 32) hist[F.tid] = 0u;
        __syncthreads();
        const int tbase = chunk * 128 + F.wave * 16;
        f32x4 nh[4]; v2u nhb[4], nm[4];
        if constexpr (!PRES) {
#pragma unroll
        for (int j = 0; j < 4; ++j) { if (HIN_F32) nh[j] = ((const f32x4*)(Hf + (size_t)tbase * D))[lane + 64 * j]; else nhb[j] = ((const v2u*)(Hb + (size_t)tbase * D))[lane + 64 * j];
            if (!PRES) nm[j] = ((const v2u*)(M + (size_t)tbase * D))[lane + 64 * j]; } }
        auto tok = [&](const int i) __attribute__((always_inline)) {
            const int t = tbase + i, tn = tbase + (i < 15 ? i + 1 : i);
            f32x4 v[4]; float s = 0.f;
#pragma unroll
            for (int j = 0; j < 4; ++j) { if (HIN_F32) v[j] = nh[j]; else v[j] = (f32x4){bflo(nhb[j].x), bfhi(nhb[j].x), bflo(nhb[j].y), bfhi(nhb[j].y)};
                if (!PRES) { v[j].x += bflo(nm[j].x); v[j].y += bfhi(nm[j].x); v[j].z += bflo(nm[j].y); v[j].w += bfhi(nm[j].y); } }
#pragma unroll
            for (int j = 0; j < 4; ++j) { if (HIN_F32) nh[j] = ((const f32x4*)(Hf + (size_t)tn * D))[lane + 64 * j]; else nhb[j] = ((const v2u*)(Hb + (size_t)tn * D))[lane + 64 * j];
                if (!PRES) nm[j] = ((const v2u*)(M + (size_t)tn * D))[lane + 64 * j]; }
#pragma unroll
            for (int j = 0; j < 4; ++j) { if (!PRES) { v2u hw; hw.x = pg8::cvt_pk_bf16(v[j].x, v[j].y); hw.y = pg8::cvt_pk_bf16(v[j].z, v[j].w); ((v2u*)(H + (size_t)t * D))[lane + 64 * j] = hw; }
                s += (v[j].x * v[j].x + v[j].y * v[j].y) + (v[j].z * v[j].z + v[j].w * v[j].w); }
            const float r = 1.0f / sqrtf(wave_sum(s) * (1.0f / D) + EPS);
            unsigned* q8 = (unsigned*)(XN8 + (size_t)t * D) + lane;
#pragma unroll
            for (int j = 0; j < 4; ++j) q8[64 * j] = pg8::pack4_fp8(v[j] * r * gg[j]);
            if (lane == 0) rtok[i] = r;
        };
        if constexpr (PRES) {
            v2u rb[8][4];
#pragma unroll
            for (int q = 0; q < 8; ++q)
#pragma unroll
                for (int j = 0; j < 4; ++j) rb[q][j] = ((const v2u*)(Hb + (size_t)(tbase + q) * D))[lane + 64 * j];
#pragma unroll
            for (int i = 0; i < 16; ++i) { const int q = i & 7, t = tbase + i;
                f32x4 v[4]; float s = 0.f;
#pragma unroll
                for (int j = 0; j < 4; ++j) v[j] = (f32x4){bflo(rb[q][j].x), bfhi(rb[q][j].x), bflo(rb[q][j].y), bfhi(rb[q][j].y)};
                if (i + 8 < 16) {
#pragma unroll
                    for (int j = 0; j < 4; ++j) rb[q][j] = ((const v2u*)(Hb + (size_t)(t + 8) * D))[lane + 64 * j]; }
#pragma unroll
                for (int j = 0; j < 4; ++j) s += (v[j].x * v[j].x + v[j].y * v[j].y) + (v[j].z * v[j].z + v[j].w * v[j].w);
                const float r = 1.0f / sqrtf(wave_sum(s) * (1.0f / D) + EPS);
                unsigned* q8 = (unsigned*)(XN8 + (size_t)t * D) + lane;
#pragma unroll
                for (int j = 0; j < 4; ++j) q8[64 * j] = pg8::pack4_fp8(v[j] * r * gg[j]);
                if (lane == 0) rtok[i] = r;
            }
        } else {
            tok(0);
            for (int i = 1; i < 16; ++i) tok(i);
        }
        if constexpr (!PRES) asm volatile("s_waitcnt vmcnt(0)" ::: "memory");
        f32x4 acc[3];
#pragma unroll
        for (int nt = 0; nt < 3; ++nt) acc[nt] = (f32x4){0.f, 0.f, 0.f, 0.f};
#pragma unroll
        for (int kh = 0; kh < 2; ++kh) {
            bf16x8 af[16];
#pragma unroll
            for (int k = 0; k < 16; ++k) af[k] = *(const bf16x8*)(H + (size_t)(tbase + fr) * D + 32 * (16 * kh + k) + 8 * fq);
            asm volatile("" : "+v"(af[0]), "+v"(af[1]), "+v"(af[2]), "+v"(af[3]), "+v"(af[4]), "+v"(af[5]), "+v"(af[6]), "+v"(af[7]), "+v"(af[8]), "+v"(af[9]), "+v"(af[10]), "+v"(af[11]), "+v"(af[12]), "+v"(af[13]), "+v"(af[14]), "+v"(af[15]));
#pragma unroll
            for (int k = 0; k < 16; ++k) { const int ks = 16 * kh + k;
#pragma unroll
                for (int nt = 0; nt < 3; ++nt) { const bf16x8 bfv = *(const LAS bf16x8*)(wimg + (16 * nt + fr) * 2048 + 16 * ((4 * ks + fq) ^ fr));
                    acc[nt] = __builtin_amdgcn_mfma_f32_16x16x32_bf16(af[k], bfv, acc[nt], 0, 0, 0); } }
        }
#pragma unroll
        for (int nt = 0; nt < 3; ++nt)
#pragma unroll
            for (int rg = 0; rg < 4; ++rg) lgt[(4 * fq + rg) * 48 + 16 * nt + fr] = acc[nt][rg];
        if (lane < 16) {
            const LAS float* lr = lgt + lane * 48; const float rt = rtok[lane];
            int gs = 0; float gm = lr[0] * rt + rbias[0]; float lg4[4]; lg4[0] = gm;
#pragma unroll
            for (int o = 1; o < 4; ++o) { lg4[o] = lr[o] * rt + rbias[o]; if (lg4[o] > gm) { gm = lg4[o]; gs = o; } }
            float den = 0.f;
#pragma unroll
            for (int o = 0; o < 4; ++o) den += __expf(lg4[o] - gm);
            const float pg = 1.0f / den;
            int i1 = 0, i2 = 1; float v1 = -3.0e38f, v2 = -3.0e38f;
#pragma unroll
            for (int o = 0; o < 8; ++o) { const float x = lr[4 + gs * 8 + o] * rt + rbias[4 + gs * 8 + o];
                if (x > v1) { v2 = v1; i2 = i1; v1 = x; i1 = o; } else if (x > v2) { v2 = x; i2 = o; } }
            const float e2 = __expf(v2 - v1), w1 = pg / (1.0f + e2), w2 = pg * e2 / (1.0f + e2);
            const int tt = F.wave * 16 + lane, ea = gs * 8 + i1, eb = gs * 8 + i2;
            te[tt * 2] = ea; te[tt * 2 + 1] = eb; tw[tt * 2] = w1; tw[tt * 2 + 1] = w2;
            tr[tt * 2] = (int)__hip_atomic_fetch_add(&hist[ea], 1u, __ATOMIC_RELAXED, __HIP_MEMORY_SCOPE_WORKGROUP); tr[tt * 2 + 1] = (int)__hip_atomic_fetch_add(&hist[eb], 1u, __ATOMIC_RELAXED, __HIP_MEMORY_SCOPE_WORKGROUP);
        }
        __syncthreads();
        if (F.tid < 32) base[F.tid] = __hip_atomic_fetch_add(cnt + F.tid * 64, hist[F.tid], __ATOMIC_RELAXED, __HIP_MEMORY_SCOPE_AGENT);
        __syncthreads();
        if (F.tid < 256) { const int e = te[F.tid]; const int pos = (int)base[e] + tr[F.tid]; const int a = chunk * 256 + F.tid;
            list[e * LISTCAP + pos] = a; gwt[e * LISTCAP + pos] = tw[F.tid]; }
        __syncthreads();
    }
}

struct CombIn { v2u h[4]; unsigned a[4], b[4]; };
__device__ __forceinline__ void comb_load(CombIn& c, const bf16* H, const unsigned char* Y, int t, int lane) {
#pragma unroll
    for (int j = 0; j < 4; ++j) { c.h[j] = ((const v2u*)(H + (size_t)t * D))[lane + 64 * j]; c.a[j] = ((const unsigned*)(Y + (size_t)(2 * t) * D))[lane + 64 * j]; c.b[j] = ((const unsigned*)(Y + (size_t)(2 * t + 1) * D))[lane + 64 * j]; }
}
template <bool FINAL> __device__ __forceinline__ void comb_row(const CombIn& c, const f32x4 (&gg)[4], bf16* H, float* OUT, float* RROW, int t, int lane, const bool dry) {
    unsigned char* A8 = (unsigned char*)RROW - WS_RROW + WS_XN;
    f32x4 v[4]; float s = 0.f;
#pragma unroll
    for (int j = 0; j < 4; ++j) { const v2u h = c.h[j]; const f32x2 a0 = __builtin_amdgcn_cvt_pk_f32_fp8((int)c.a[j], false), a1 = __builtin_amdgcn_cvt_pk_f32_fp8((int)c.a[j], true), b0 = __builtin_amdgcn_cvt_pk_f32_fp8((int)c.b[j], false), b1 = __builtin_amdgcn_cvt_pk_f32_fp8((int)c.b[j], true);
        v[j].x = bflo(h.x) + (a0.x + b0.x) * (1.0f / Y_SCALE); v[j].y = bfhi(h.x) + (a0.y + b0.y) * (1.0f / Y_SCALE); v[j].z = bflo(h.y) + (a1.x + b1.x) * (1.0f / Y_SCALE); v[j].w = bfhi(h.y) + (a1.y + b1.y) * (1.0f / Y_SCALE);
        s += (v[j].x * v[j].x + v[j].y * v[j].y) + (v[j].z * v[j].z + v[j].w * v[j].w); }
    const float r = 1.0f / sqrtf(wave_sum(s) * (1.0f / D) + EPS);
    if (dry) { asm volatile("" :: "v"(v[0].x * r), "v"(v[1].y), "v"(v[2].z), "v"(v[3].w)); }
    else if (FINAL) {
        f32x4* orow = (f32x4*)(OUT + (size_t)t * D) + lane;
#pragma unroll
        for (int j = 0; j < 4; ++j) orow[64 * j] = v[j] * r * gg[j];
    } else {
        v2u* hr = (v2u*)(H + (size_t)t * D) + lane; float mx = 0.f;
#pragma unroll
        for (int j = 0; j < 4; ++j) { v2u hw; hw.x = pg8::cvt_pk_bf16(v[j].x, v[j].y); hw.y = pg8::cvt_pk_bf16(v[j].z, v[j].w); hr[64 * j] = hw;
            mx = fmaxf(fmaxf(mx, fmaxf(fabsf(v[j].x), fabsf(v[j].y))), fmaxf(fabsf(v[j].z), fabsf(v[j].w))); }
        mx = wave_max(mx); mx = mx > 0.f ? mx : 1.0f;
        { unsigned* q8 = (unsigned*)(A8 + (size_t)t * D) + lane; const float inv = 127.0f / mx;
#pragma unroll
          for (int j = 0; j < 4; ++j) q8[64 * j] = pack4_i8(v[j], inv); }
        if (lane == 0) RROW[t] = r * mx * (1.0f / 127.0f);
    }
}
template <bool FINAL> __device__ __forceinline__ void phase_combine(Frame& F, const float* g, const bool dry = false) {
    bf16* H = (bf16*)(F.ws + WS_H); float* OUT = F.p.out; const unsigned char* Y = F.ws + WS_B; float* RROW = (float*)(F.ws + WS_RROW);
    const int gw = F.wg * NWAVES + F.wave, NGW = F.nwg * NWAVES, lane = F.lane;
    f32x4 gg[4];
#pragma unroll
    for (int j = 0; j < 4; ++j) gg[j] = ((const f32x4*)g)[lane + 64 * j];
    if (gw >= T) return;
    CombIn c0, c1;
    comb_load(c0, H, Y, gw, lane); comb_load(c1, H, Y, gw + NGW < T ? gw + NGW : gw, lane);
    auto pair = [&](const int t) __attribute__((always_inline)) {
        const int t1 = t + NGW, t2 = t + 2 * NGW, t3 = t + 3 * NGW;
        comb_row<FINAL>(c0, gg, H, OUT, RROW, t, lane, dry);
        comb_load(c0, H, Y, t2 < T ? t2 : t, lane);
        if (t1 < T) comb_row<FINAL>(c1, gg, H, OUT, RROW, t1, lane, dry);
        comb_load(c1, H, Y, t3 < T ? t3 : t, lane);
    };
    pair(gw);
    for (int t = gw + 2 * NGW; t < T; t += 2 * NGW) pair(t);
}

__device__ __forceinline__ unsigned sgu_off(int r, int ch) { return (unsigned)(r * 512 + 16 * (ch ^ (2 * ((r & 3) | (((r >> 3) & 1) << 2))))); }
__device__ __forceinline__ void phase_sgu(Frame& F, const bool dry = false) {
    LAS unsigned char* vs = F.lds; LAS float* rs = (LAS float*)(F.lds + 65536);
    bf16* U = (bf16*)(F.ws + WS_A); const bf16* V = (const bf16*)(F.ws + WS_B); const float* SSQ = (const float*)(F.ws + WS_SSQ);
    const bf16* WST = (const bf16*)(F.ws + WS_WST); const float* vg = F.p.in[I_GVG]; const float* bs = F.p.in[I_GBS];
    const int lane = F.lane, fr = lane & 15, fq = lane >> 4, wm = F.wave >> 2, wn = F.wave & 3;
    const unsigned vsb = (unsigned)(size_t)vs;
    const int q = (lane & 15) >> 2, pp = lane & 3;
    const int srow = F.tid >> 2, spc = (F.tid & 3) * 2;
    int hcur = -1;
    bf16x8 wsf[4][4];
    LAS float* vgl = (LAS float*)(F.lds + 65536 + 1024); LAS float* bsl = vgl + 256;
#pragma unroll
    for (int a = 0; a < 4; ++a)
#pragma unroll
        for (int k = 0; k < 4; ++k) wsf[a][k] = (bf16x8){0, 0, 0, 0, 0, 0, 0, 0};
    const int nunits = (T / GB) * GH;
    int par = 0;
    if (F.wg < nunits) {
        const f32x4* sp = (const f32x4*)(SSQ + (size_t)((F.wg / GH) * GB + srow) * 32) + spc; const f32x4 x0 = sp[0], x1 = sp[1];
        float sm = ((x0.x + x0.y) + (x0.z + x0.w)) + ((x1.x + x1.y) + (x1.z + x1.w)); sm += __shfl_xor(sm, 1); sm += __shfl_xor(sm, 2);
        if ((F.tid & 3) == 0) rs[srow] = 1.0f / sqrtf(sm * (1.0f / GI) + EPS);
    }
    for (int unit = F.wg; unit < nunits; unit += F.nwg) {
        const int nb = unit / GH, h = unit % GH, un = unit + F.nwg;
        if (h != hcur) { hcur = h;
#pragma unroll
            for (int a = 0; a < 4; ++a) { const int it = (a < 2) ? (2 * wm + a) : (4 + 2 * wm + (a - 2));
#pragma unroll
                for (int k = 0; k < 4; ++k) if (a >= 2 || k < 2) wsf[a][k] = *(const bf16x8*)(WST + ((size_t)h * GB + it * 16 + fr) * GB + k * 32 + 8 * fq); }
            __syncthreads();
            if (F.tid < 256) vgl[F.tid] = vg[h * GHD + F.tid]; else if (F.tid < 384) bsl[F.tid - 256] = bs[h * GB + (F.tid - 256)]; }
        __syncthreads();
        const LAS float* rsc = rs + par * 128;
        f32x4 sq0 = (f32x4){0.f, 0.f, 0.f, 0.f}, sq1 = sq0;
        if (un < nunits) { const f32x4* sp = (const f32x4*)(SSQ + (size_t)((un / GH) * GB + srow) * 32) + spc; sq0 = sp[0]; sq1 = sp[1]; }
        {
            v4u xv[8];
#pragma unroll
            for (int i8 = 0; i8 < 8; ++i8) { const int p = F.tid + 512 * i8, j = p >> 5, ch = p & 31; xv[i8] = *(const v4u*)(V + ((size_t)h * T + nb * GB + j) * GHD + ch * 8); }
            asm volatile("" : "+v"(xv[0].x), "+v"(xv[1].x), "+v"(xv[2].x), "+v"(xv[3].x), "+v"(xv[4].x), "+v"(xv[5].x), "+v"(xv[6].x), "+v"(xv[7].x));
#pragma unroll
            for (int i8 = 0; i8 < 8; ++i8) { const int p = F.tid + 512 * i8, j = p >> 5, ch = p & 31; const float r = rsc[j]; const v4u x = xv[i8];
                v4u o; o.x = pg8::cvt_pk_bf16(bflo(x.x) * r, bfhi(x.x) * r); o.y = pg8::cvt_pk_bf16(bflo(x.y) * r, bfhi(x.y) * r); o.z = pg8::cvt_pk_bf16(bflo(x.z) * r, bfhi(x.z) * r); o.w = pg8::cvt_pk_bf16(bflo(x.w) * r, bfhi(x.w) * r);
                *(LAS v4u*)(vs + sgu_off(j, ch)) = o; }
        }
        float smn = ((sq0.x + sq0.y) + (sq0.z + sq0.w)) + ((sq1.x + sq1.y) + (sq1.z + sq1.w));
        v4u uu[4][2];
#pragma unroll
        for (int a = 0; a < 4; ++a) { const int it = (a < 2) ? (2 * wm + a) : (4 + 2 * wm + (a - 2));
#pragma unroll
            for (int cp = 0; cp < 2; ++cp) uu[a][cp] = *(const v4u*)(U + ((size_t)h * T + nb * GB + it * 16 + fr) * GHD + 64 * wn + 32 * cp + 8 * fq); }
        __syncthreads();
        f32x4 acc[4][4];
#pragma unroll
        for (int a = 0; a < 4; ++a)
#pragma unroll
            for (int c = 0; c < 4; ++c) acc[a][c] = (f32x4){0.f, 0.f, 0.f, 0.f};
#pragma unroll
        for (int ks = 0; ks < 4; ++ks) {
            typedef short s16x4 __attribute__((ext_vector_type(4))); s16x4 t0, t1, t2, t3, t4, t5, t6, t7;
            const unsigned r0 = vsb + sgu_off(32 * ks + 8 * fq + q, 8 * wn + pp), r1 = vsb + sgu_off(32 * ks + 8 * fq + 4 + q, 8 * wn + pp);
            const unsigned r2 = vsb + sgu_off(32 * ks + 8 * fq + q, 8 * wn + 4 + pp), r3 = vsb + sgu_off(32 * ks + 8 * fq + 4 + q, 8 * wn + 4 + pp);
            asm volatile("ds_read_b64_tr_b16 %0, %8\n\tds_read_b64_tr_b16 %1, %9\n\tds_read_b64_tr_b16 %2, %8 offset:8\n\tds_read_b64_tr_b16 %3, %9 offset:8\n\t"
                         "ds_read_b64_tr_b16 %4, %10\n\tds_read_b64_tr_b16 %5, %11\n\tds_read_b64_tr_b16 %6, %10 offset:8\n\tds_read_b64_tr_b16 %7, %11 offset:8\n\ts_waitcnt lgkmcnt(0)"
                         : "=&v"(t0), "=&v"(t1), "=&v"(t2), "=&v"(t3), "=&v"(t4), "=&v"(t5), "=&v"(t6), "=&v"(t7) : "v"(r0), "v"(r1), "v"(r2), "v"(r3) : "memory");
            bf16x8 vf[4];
            vf[0] = (bf16x8){t0[0], t0[1], t0[2], t0[3], t1[0], t1[1], t1[2], t1[3]}; vf[1] = (bf16x8){t2[0], t2[1], t2[2], t2[3], t3[0], t3[1], t3[2], t3[3]};
            vf[2] = (bf16x8){t4[0], t4[1], t4[2], t4[3], t5[0], t5[1], t5[2], t5[3]}; vf[3] = (bf16x8){t6[0], t6[1], t6[2], t6[3], t7[0], t7[1], t7[2], t7[3]};
            __builtin_amdgcn_sched_barrier(0);
#pragma unroll
            for (int a = 0; a < 4; ++a) { if (a < 2 && ks >= 2) continue;
#pragma unroll
                for (int c = 0; c < 4; ++c) acc[a][c] = __builtin_amdgcn_mfma_f32_16x16x32_bf16(vf[c], wsf[a][ks], acc[a][c], 0, 0, 0); }
        }
#pragma unroll
        for (int cp = 0; cp < 2; ++cp) { const int c0 = h * GHD + 64 * wn + 32 * cp + 8 * fq; const f32x4 g0 = *(const LAS f32x4*)(vgl + 64 * wn + 32 * cp + 8 * fq), g1 = *(const LAS f32x4*)(vgl + 64 * wn + 32 * cp + 8 * fq + 4);
#pragma unroll
            for (int a = 0; a < 4; ++a) { const int it = (a < 2) ? (2 * wm + a) : (4 + 2 * wm + (a - 2)); const int i = it * 16 + fr; const float bsi = bsl[i];
                const v4u x = uu[a][cp];
                f32x4 u0 = (f32x4){bflo(x.x), bfhi(x.x), bflo(x.y), bfhi(x.y)}, u1 = (f32x4){bflo(x.z), bfhi(x.z), bflo(x.w), bfhi(x.w)};
                u0 = u0 * (g0 * acc[a][2 * cp] + bsi); u1 = u1 * (g1 * acc[a][2 * cp + 1] + bsi);
                v2u pk; pk.x = pg8::pack4_fp8(u0 * 16.0f); pk.y = pg8::pack4_fp8(u1 * 16.0f); if (dry) { asm volatile("" :: "v"(pk.x), "v"(pk.y)); } else *(v2u*)(F.ws + WS_XN + (size_t)(nb * GB + i) * GI + c0) = pk; } }
        { smn += __shfl_xor(smn, 1); smn += __shfl_xor(smn, 2);
          if ((F.tid & 3) == 0) rs[(par ^ 1) * 128 + srow] = 1.0f / sqrtf(smn * (1.0f / GI) + EPS); }
        par ^= 1;
    }
}

namespace pg8 {
constexpr int BM = 256, BK = 64, HALF = 128, HTB = HALF * BK * 2, STAGE_BYTES = 8 * HTB, NXCD = 8, WGM = 8;
__device__ __forceinline__ int lds_byte(int r, int c) { const int st = (r >> 4) * 2 + (c >> 5), rr = r & 15, cc = c & 31, ob = rr * 64 + cc * 2; return st * 1024 + (ob ^ (((ob >> 9) & 1) << 5)); }
__device__ __forceinline__ void stage_rc(int b, int& R, int& C) { const int st = b / 1024, sb = b % 1024, swz = sb ^ (((sb >> 9) & 1) << 5); R = (st >> 1) * 16 + swz / 64; C = (st & 1) * 32 + (swz % 64) / 2; }
__device__ __forceinline__ int perm32(int rho) { const int n = rho >> 4, i = rho & 15; return 8 * (i >> 2) + 4 * n + (i & 3); }

struct Unit { int pm, pn, e, rb, nvalid; };

struct DenseOrder {
    static constexpr bool GATHER = false;
    const char* A; const char* Bt; int K, nM, nN, nwg, G, c;
    __device__ __forceinline__ void init(const void* A_, const void* Bt_, int M, int N, int K_, int G_, int c_) { A = (const char*)A_; Bt = (const char*)Bt_; K = K_; nM = M / BM; nN = N / BM; nwg = nM * nN; G = G_; c = c_; }
    __device__ __forceinline__ bool next(int i, Unit& u) const {
        const long L = (long)i * G + c; if (L >= nwg) return false;
        int wgid = (int)L; { const int q = nwg / NXCD, r = nwg % NXCD, xcd = wgid % NXCD, off = wgid / NXCD; wgid = (xcd < r ? xcd * (q + 1) : r * (q + 1) + (xcd - r) * q) + off; }
        const int nig = WGM * nN, gid = wgid / nig, fm = gid * WGM, gsz = (nM - fm) < WGM ? (nM - fm) : WGM;
        u.pm = fm + ((wgid % nig) % gsz); u.pn = (wgid % nig) / gsz; u.e = 0; u.rb = 0; u.nvalid = 256; return true;
    }
    __device__ __forceinline__ const char* a_base(const Unit& u) const { return A + (size_t)u.pm * BM * K * 2; }
    __device__ __forceinline__ const char* b_base(const Unit& u) const { return Bt + (size_t)u.pn * BM * K * 2; }
    __device__ __forceinline__ const char* a_origin() const { return A; }
    __device__ __forceinline__ void a_offs(const Unit&, int, int, unsigned (&)[2][2]) const {}
    __device__ __forceinline__ void a_offs_load(const Unit&, int, unsigned (&)[2][2]) const {}
    __device__ __forceinline__ void a_offs_finish(const Unit&, int, int, const unsigned (&)[2][2], unsigned (&)[2][2]) const {}
};
struct DenseOrderG : DenseOrder {
    static constexpr bool GATHER = true;
    __device__ __forceinline__ void a_offs_load(const Unit& u, int R0, unsigned (&raw)[2][2]) const {
#pragma unroll
        for (int h = 0; h < 2; ++h)
#pragma unroll
            for (int i = 0; i < 2; ++i) raw[h][i] = (unsigned)(u.pm * 256 + h * 128 + i * 64 + R0); }
    __device__ __forceinline__ void a_offs_finish(const Unit&, int, int C2, const unsigned (&raw)[2][2], unsigned (&o)[2][2]) const {
#pragma unroll
        for (int h = 0; h < 2; ++h)
#pragma unroll
            for (int i = 0; i < 2; ++i) o[h][i] = raw[h][i] * (unsigned)(K * 2) + (unsigned)C2; }
    __device__ __forceinline__ void a_offs(const Unit& u, int R0, int C2, unsigned (&o)[2][2]) const { unsigned raw[2][2]; a_offs_load(u, R0, raw); a_offs_finish(u, R0, C2, raw, o); }
};
template <bool LISTED> struct MoeOrder {
    static constexpr bool GATHER = true;
    const char* A; const char* Bt; const int* list; int K, G, c; LAS unsigned* tab;
    __device__ __forceinline__ void init(const void* A_, const void* Bt_, const int* list_, const unsigned* cnt, int K_, int G_, int c_, int lane, int wave, LAS unsigned* tab_, bool reuse = false) {
        A = (const char*)A_; Bt = (const char*)Bt_; list = list_; K = K_; G = G_; c = c_; tab = tab_;
        if (reuse) return;
        if (wave == 0) {
            const unsigned cntv = lane < 32 ? __hip_atomic_load(cnt + lane * 64, __ATOMIC_RELAXED, __HIP_MEMORY_SCOPE_AGENT) : 0u;
            unsigned inc = (cntv + 255u) >> 8;
#pragma unroll
            for (int o = 1; o < 64; o <<= 1) { const unsigned t = __shfl_up(inc, o); if (lane >= o) inc += t; }
            unsigned pbv = inc - ((cntv + 255u) >> 8);
            if (lane > 32) pbv = 0xffffffffu;
            tab[lane] = pbv; if (lane < 32) tab[64 + lane] = cntv;
        }
        __syncthreads();
    }
    __device__ __forceinline__ bool next(int i, Unit& u) const {
        const int tot = (int)tab[32] * 4;
        const int L = i * G + (c & 7) * (G >> 3) + (c >> 3); if (L >= tot) return false;
        const int b = L >> 2; u.pm = b; u.pn = L & 3;
        int ln_ = threadIdx.x & 63; asm volatile("" : "+v"(ln_));
        const unsigned pbv = tab[ln_];
        const int e = __builtin_popcountll(__ballot((int)(pbv <= (unsigned)b))) - 1;
        u.e = e; u.rb = b - (int)__builtin_amdgcn_readlane(pbv, e);
        const int left = (int)tab[64 + e] - u.rb * 256; u.nvalid = left < 256 ? left : 256; return true;
    }
    __device__ __forceinline__ const char* a_base(const Unit& u) const { return A + (size_t)u.pm * BM * K * 2; }
    __device__ __forceinline__ const char* b_base(const Unit& u) const { return Bt + ((size_t)u.e * D + (size_t)u.pn * BM) * K * 2; }
    __device__ __forceinline__ const char* a_origin() const { return A; }
    __device__ __forceinline__ void a_offs_load(const Unit& u, int R0, unsigned (&raw)[2][2]) const {
#pragma unroll
        for (int h = 0; h < 2; ++h)
#pragma unroll
            for (int i = 0; i < 2; ++i) { const int idx = h * 128 + i * 64 + R0;
                if constexpr (LISTED) raw[h][i] = (unsigned)list[u.e * LISTCAP + u.rb * 256 + (idx < u.nvalid ? idx : 0)];
                else raw[h][i] = (unsigned)(u.pm * 256 + idx); }
    }
    __device__ __forceinline__ void a_offs_finish(const Unit& u, int R0, int C2, const unsigned (&raw)[2][2], unsigned (&o)[2][2]) const {
#pragma unroll
        for (int h = 0; h < 2; ++h)
#pragma unroll
            for (int i = 0; i < 2; ++i) { const int idx = h * 128 + i * 64 + R0;
                if constexpr (LISTED) o[h][i] = (idx < u.nvalid ? (raw[h][i] >> 1) : 0u) * (unsigned)(K * 2) + (unsigned)C2;
                else o[h][i] = raw[h][i] * (unsigned)(K * 2) + (unsigned)C2; }
    }
    __device__ __forceinline__ void a_offs(const Unit& u, int R0, int C2, unsigned (&o)[2][2]) const { unsigned raw[2][2]; a_offs_load(u, R0, raw); a_offs_finish(u, R0, C2, raw, o); }
};

struct FEpiGlu {
    static constexpr bool PERM = true, PERM16 = false; bf16* Z; const float* bias; const float* rrow; const unsigned* wmax;
    struct Row { float r; };
    __device__ __forceinline__ void row_load(const Unit& u, int tid, Row& rw) const { rw.r = rrow[u.pm * BM + (tid & 255)] * (wmax8(wmax + u.pn * 128) * (1.0f / 127.0f)); }
    __device__ __forceinline__ void row_store(LAS unsigned char* buf, int tid, const Row& rw) const { ((LAS float*)buf)[tid & 255] = rw.r; }
    __device__ __forceinline__ void stage(LAS float* lb, int tid) const { for (int i = tid; i < 2048 / 4; i += NTHREADS) ((LAS f32x4*)lb)[i] = ((const f32x4*)bias)[i]; }
    __device__ __forceinline__ void operator()(const f32x4 (&acc)[2][2][4][2], const Unit& u, int wr, int wc, int fr, int fq, const LAS unsigned char* rowbuf, const LAS float* lb) const {
        const int row0 = u.pm * BM + wr * 64 + fr, col0 = u.pn * 128 + wc * 32 + 8 * fq; const LAS float* rl = (const LAS float*)rowbuf + wr * 64 + fr;
        const f32x4 ba0 = *(const LAS f32x4*)(lb + col0), ba1 = *(const LAS f32x4*)(lb + col0 + 4), bg0 = *(const LAS f32x4*)(lb + 1024 + col0), bg1 = *(const LAS f32x4*)(lb + 1024 + col0 + 4);
#pragma unroll
        for (int ai = 0; ai < 2; ++ai)
#pragma unroll
            for (int m = 0; m < 4; ++m) { bf16* rowp = Z + (size_t)(row0 + ai * HALF + m * 16) * D + col0; const float rr = rl[ai * HALF + m * 16];
                f32x4 s0 = acc[ai][1][m][0] * rr + bg0, s1 = acc[ai][1][m][1] * rr + bg1; act_poly8<false>(s0, s1); const f32x4 z0 = (acc[ai][0][m][0] * rr + ba0) * s0, z1 = (acc[ai][0][m][1] * rr + ba1) * s1;
                *(v4u*)rowp = pack8(z0, z1); }
    }
};
struct FEpiBf16S {
    static constexpr bool PERM = true, PERM16 = false; bf16* O; const float* bias; const float* rrow; const unsigned* wmax;
    struct Row { float r; };
    __device__ __forceinline__ void row_load(const Unit& u, int tid, Row& rw) const { rw.r = rrow[u.pm * BM + (tid & 255)] * (wmax8(wmax + u.pn * 128) * (1.0f / 127.0f)); }
    __device__ __forceinline__ void row_store(LAS unsigned char* buf, int tid, const Row& rw) const { ((LAS float*)buf)[tid & 255] = rw.r; }
    __device__ __forceinline__ void stage(LAS float* lb, int tid) const { for (int i = tid; i < 1024 / 4; i += NTHREADS) ((LAS f32x4*)lb)[i] = ((const f32x4*)bias)[i]; }
    __device__ __forceinline__ void operator()(const f32x4 (&acc)[2][2][4][2], const Unit& u, int wr, int wc, int fr, int fq, const LAS unsigned char* rowbuf, const LAS float* lb) const {
        const int row0 = u.pm * BM + wr * 64 + fr, col0 = u.pn * BM + wc * 32 + 8 * fq; const LAS float* rl = (const LAS float*)rowbuf + wr * 64 + fr;
        f32x4 bv[2][2];
#pragma unroll
        for (int bj = 0; bj < 2; ++bj)
#pragma unroll
            for (int n = 0; n < 2; ++n) bv[bj][n] = *(const LAS f32x4*)(lb + col0 + bj * HALF + 4 * n);
#pragma unroll
        for (int ai = 0; ai < 2; ++ai)
#pragma unroll
            for (int m = 0; m < 4; ++m) { bf16* rowp = O + (size_t)(row0 + ai * HALF + m * 16) * D + col0; const float rr = rl[ai * HALF + m * 16];
#pragma unroll
                for (int bj = 0; bj < 2; ++bj) *(v4u*)(rowp + bj * HALF) = pack8(acc[ai][bj][m][0] * rr + bv[bj][0], acc[ai][bj][m][1] * rr + bv[bj][1]); }
    }
};
struct FEpiBf16 {
    static constexpr bool PERM = true, PERM16 = false; bf16* O; const float* bias;
    struct Row {}; __device__ __forceinline__ void row_load(const Unit&, int, Row&) const {} __device__ __forceinline__ void row_store(LAS unsigned char*, int, const Row&) const {}
    __device__ __forceinline__ void stage(LAS float* lb, int tid) const { for (int i = tid; i < 1024 / 4; i += NTHREADS) ((LAS f32x4*)lb)[i] = ((const f32x4*)bias)[i]; }
    __device__ __forceinline__ void operator()(const f32x4 (&acc)[2][2][4][2], const Unit& u, int wr, int wc, int fr, int fq, const LAS unsigned char*, const LAS float* lb) const {
        const int row0 = u.pm * BM + wr * 64 + fr, col0 = u.pn * BM + wc * 32 + 8 * fq;
        f32x4 bv[2][2];
#pragma unroll
        for (int bj = 0; bj < 2; ++bj)
#pragma unroll
            for (int n = 0; n < 2; ++n) bv[bj][n] = *(const LAS f32x4*)(lb + col0 + bj * HALF + 4 * n);
#pragma unroll
        for (int ai = 0; ai < 2; ++ai)
#pragma unroll
            for (int m = 0; m < 4; ++m) { bf16* rowp = O + (size_t)(row0 + ai * HALF + m * 16) * D + col0;
#pragma unroll
                for (int bj = 0; bj < 2; ++bj) *(v4u*)(rowp + bj * HALF) = pack8(acc[ai][bj][m][0] + bv[bj][0], acc[ai][bj][m][1] + bv[bj][1]); }
    }
};
struct FEpiBf16R {
    static constexpr float ASC = 1.0f / 512.0f;
    static constexpr bool PERM = true, PERM16 = false; bf16* H; const float* bias;
    struct Row {}; __device__ __forceinline__ void row_load(const Unit&, int, Row&) const {} __device__ __forceinline__ void row_store(LAS unsigned char*, int, const Row&) const {}
    __device__ __forceinline__ void stage(LAS float* lb, int tid) const { for (int i = tid; i < 1024 / 4; i += NTHREADS) ((LAS f32x4*)lb)[i] = ((const f32x4*)bias)[i]; }
    __device__ __forceinline__ void operator()(const f32x4 (&acc)[2][2][4][2], const Unit& u, int wr, int wc, int fr, int fq, const LAS unsigned char*, const LAS float* lb) const {
        const int row0 = u.pm * BM + wr * 64 + fr, col0 = u.pn * BM + wc * 32 + 8 * fq;
        f32x4 bv[2][2];
#pragma unroll
        for (int bj = 0; bj < 2; ++bj)
#pragma unroll
            for (int n = 0; n < 2; ++n) bv[bj][n] = *(const LAS f32x4*)(lb + col0 + bj * HALF + 4 * n);
#pragma unroll
        for (int ai = 0; ai < 2; ++ai) {
            v4u hv[4][2];
#pragma unroll
            for (int m = 0; m < 4; ++m)
#pragma unroll
                for (int bj = 0; bj < 2; ++bj) hv[m][bj] = *(const v4u*)(H + (size_t)(row0 + ai * HALF + m * 16) * D + col0 + bj * HALF);
            asm volatile("" : "+v"(hv[0][0].x), "+v"(hv[0][1].x), "+v"(hv[1][0].x), "+v"(hv[1][1].x), "+v"(hv[2][0].x), "+v"(hv[2][1].x), "+v"(hv[3][0].x), "+v"(hv[3][1].x));
#pragma unroll
            for (int m = 0; m < 4; ++m) { bf16* rowp = H + (size_t)(row0 + ai * HALF + m * 16) * D + col0;
#pragma unroll
                for (int bj = 0; bj < 2; ++bj) { const v4u x = hv[m][bj];
                    const f32x4 h0 = (f32x4){bflo(x.x), bfhi(x.x), bflo(x.y), bfhi(x.y)}, h1 = (f32x4){bflo(x.z), bfhi(x.z), bflo(x.w), bfhi(x.w)};
                    *(v4u*)(rowp + bj * HALF) = pack8(acc[ai][bj][m][0] * ASC + bv[bj][0] + h0, acc[ai][bj][m][1] * ASC + bv[bj][1] + h1); } }
        }
    }
};
struct FEpiBf16SX {
    static constexpr bool PERM = true, PERM16 = false; bf16* H; const float* bias; const float* rrow; const unsigned* wmax; const float* X;
    struct Row { float r; };
    __device__ __forceinline__ void row_load(const Unit& u, int tid, Row& rw) const { rw.r = rrow[u.pm * BM + (tid & 255)] * (wmax8(wmax + u.pn * 128) * (1.0f / 127.0f)); }
    __device__ __forceinline__ void row_store(LAS unsigned char* buf, int tid, const Row& rw) const { ((LAS float*)buf)[tid & 255] = rw.r; }
    __device__ __forceinline__ void stage(LAS float* lb, int tid) const { for (int i = tid; i < 1024 / 4; i += NTHREADS) ((LAS f32x4*)lb)[i] = ((const f32x4*)bias)[i]; }
    __device__ __forceinline__ void operator()(const f32x4 (&acc)[2][2][4][2], const Unit& u, int wr, int wc, int fr, int fq, const LAS unsigned char* rowbuf, const LAS float* lb) const {
        const int row0 = u.pm * BM + wr * 64 + fr, col0 = u.pn * BM + wc * 32 + 8 * fq; const LAS float* rl = (const LAS float*)rowbuf + wr * 64 + fr;
        f32x4 bv[2][2];
#pragma unroll
        for (int bj = 0; bj < 2; ++bj)
#pragma unroll
            for (int n = 0; n < 2; ++n) bv[bj][n] = *(const LAS f32x4*)(lb + col0 + bj * HALF + 4 * n);
#pragma unroll
        for (int ai = 0; ai < 2; ++ai) {
            f32x4 xv[4][2][2];
#pragma unroll
            for (int m = 0; m < 4; ++m)
#pragma unroll
                for (int bj = 0; bj < 2; ++bj)
#pragma unroll
                    for (int n = 0; n < 2; ++n) xv[m][bj][n] = __builtin_nontemporal_load((const f32x4*)(X + (size_t)(row0 + ai * HALF + m * 16) * D + col0 + bj * HALF + 4 * n));
            asm volatile("" : "+v"(xv[0][0][0].x), "+v"(xv[0][0][1].x), "+v"(xv[0][1][0].x), "+v"(xv[0][1][1].x), "+v"(xv[1][0][0].x), "+v"(xv[1][0][1].x), "+v"(xv[1][1][0].x), "+v"(xv[1][1][1].x),
                              "+v"(xv[2][0][0].x), "+v"(xv[2][0][1].x), "+v"(xv[2][1][0].x), "+v"(xv[2][1][1].x), "+v"(xv[3][0][0].x), "+v"(xv[3][0][1].x), "+v"(xv[3][1][0].x), "+v"(xv[3][1][1].x));
#pragma unroll
            for (int m = 0; m < 4; ++m) { bf16* rowp = H + (size_t)(row0 + ai * HALF + m * 16) * D + col0; const float rr = rl[ai * HALF + m * 16];
#pragma unroll
                for (int bj = 0; bj < 2; ++bj) *(v4u*)(rowp + bj * HALF) = pack8(acc[ai][bj][m][0] * rr + bv[bj][0] + xv[m][bj][0], acc[ai][bj][m][1] * rr + bv[bj][1] + xv[m][bj][1]); }
        }
    }
};
struct FEpiGeluUV {
    static constexpr bool PERM = true, PERM16 = false; bf16* U; bf16* V; float* SSQ; const float* bias; const float* rrow; const unsigned* wmax;
    struct Row { float r; };
    __device__ __forceinline__ void row_load(const Unit& u, int tid, Row& rw) const { rw.r = rrow[u.pm * BM + (tid & 255)] * (wmax8(wmax + u.pn * 128) * (1.0f / 127.0f)); }
    __device__ __forceinline__ void row_store(LAS unsigned char* buf, int tid, const Row& rw) const { ((LAS float*)buf)[tid & 255] = rw.r; }
    __device__ __forceinline__ void stage(LAS float* lb, int tid) const { for (int i = tid; i < 4096 / 4; i += NTHREADS) ((LAS f32x4*)lb)[i] = ((const f32x4*)bias)[i]; }
    __device__ __forceinline__ void operator()(const f32x4 (&acc)[2][2][4][2], const Unit& u, int wr, int wc, int fr, int fq, const LAS unsigned char* rowbuf, const LAS float* lb) const {
        const int row0 = u.pm * BM + wr * 64 + fr; const bool isv = u.pn >= 8; bf16* base = isv ? V : U;
        const int col0 = wc * 32 + 8 * fq, bcol0 = u.pn * BM + wc * 32 + 8 * fq; bf16* hbase = base + (size_t)(u.pn & 7) * T * GHD;     const LAS float* rl = (const LAS float*)rowbuf + wr * 64 + fr;
        f32x4 bv[2][2];
#pragma unroll
        for (int bj = 0; bj < 2; ++bj)
#pragma unroll
            for (int n = 0; n < 2; ++n) bv[bj][n] = *(const LAS f32x4*)(lb + bcol0 + bj * HALF + 4 * n);
#pragma unroll
        for (int ai = 0; ai < 2; ++ai)
#pragma unroll
            for (int m = 0; m < 4; ++m) { const int row = row0 + ai * HALF + m * 16; bf16* rowp = hbase + (size_t)row * GHD + col0; f32x2 ss2 = {0.f, 0.f}; const float rr = rl[ai * HALF + m * 16];
#pragma unroll
                for (int bj = 0; bj < 2; ++bj) { f32x4 v0 = acc[ai][bj][m][0] * rr + bv[bj][0], v1 = acc[ai][bj][m][1] * rr + bv[bj][1];
                    act_poly8<true>(v0, v1);
                    if (isv) { const f32x2 a = {v0.x, v0.y}, b = {v0.z, v0.w}, c = {v1.x, v1.y}, d = {v1.z, v1.w}; ss2 = a * a + ss2; ss2 = b * b + ss2; ss2 = c * c + ss2; ss2 = d * d + ss2; }
                    *(v4u*)(rowp + bj * HALF) = pack8(v0, v1); }
                if (isv) { float ss = ss2.x + ss2.y; ss += __shfl_xor(ss, 16); ss += __shfl_xor(ss, 32); if (fq == 0) SSQ[(size_t)row * 32 + (u.pn - 8) * 4 + wc] = ss; } }
    }
};
struct FEpiMoeGU {
    static constexpr bool PERM = true, PERM16 = false; unsigned char* HB;
    struct Row {}; __device__ __forceinline__ void row_load(const Unit&, int, Row&) const {} __device__ __forceinline__ void row_store(LAS unsigned char*, int, const Row&) const {}
    __device__ __forceinline__ void stage(LAS float*, int) const {}
    __device__ __forceinline__ void operator()(const f32x4 (&acc)[2][2][4][2], const Unit& u, int wr, int wc, int fr, int fq, const LAS unsigned char*, const LAS float*) const {
        const int row0 = u.pm * BM + wr * 64 + fr, col0 = u.pn * 128 + wc * 32 + 8 * fq;
#pragma unroll
        for (int ai = 0; ai < 2; ++ai)
#pragma unroll
            for (int m = 0; m < 4; ++m) { unsigned char* rowp = HB + (size_t)(row0 + ai * HALF + m * 16) * DE + col0;
                const f32x4 g0 = acc[ai][0][m][0], g1 = acc[ai][0][m][1];
                f32x4 s0 = g0, s1 = g1; act_poly8<false>(s0, s1); v2u w; w.x = pack4_fp8(g0 * s0 * acc[ai][1][m][0]); w.y = pack4_fp8(g1 * s1 * acc[ai][1][m][1]); *(v2u*)rowp = w; }
    }
};
struct FEpiMoeDown {
    static constexpr bool PERM = true, PERM16 = true;
    unsigned char* Y; const int* list; const float* gw; unsigned char* sink;
    struct Row { int a; float w; bool ok; };
    __device__ __forceinline__ void row_load(const Unit& u, int tid, Row& rw) const { const int r = tid & 255; rw.ok = r < u.nvalid; const int idx = u.e * LISTCAP + u.rb * 256 + (rw.ok ? r : 0);
        rw.a = list[idx]; rw.w = gw[idx]; }
    __device__ __forceinline__ void row_store(LAS unsigned char* buf, int tid, const Row& rw) const { ((LAS int*)buf)[tid & 255] = rw.ok ? rw.a : -1; ((LAS float*)(buf + 1024))[tid & 255] = rw.ok ? rw.w * Y_SCALE : 0.f; }
    __device__ __forceinline__ void stage(LAS float*, int) const {}
    __device__ __forceinline__ void operator()(const f32x4 (&acc)[2][2][4][2], const Unit& u, int wr, int wc, int fr, int fq, const LAS unsigned char* rowbuf, const LAS float*) const {
        const int col0 = u.pn * BM + wc * 64 + 16 * fq; const LAS int* al = (const LAS int*)rowbuf + wr * 64 + fr; const LAS float* wl = (const LAS float*)(rowbuf + 1024) + wr * 64 + fr;
        int a8[2][4]; float w8[2][4];
#pragma unroll
        for (int ai = 0; ai < 2; ++ai)
#pragma unroll
            for (int m = 0; m < 4; ++m) { a8[ai][m] = al[ai * HALF + m * 16]; w8[ai][m] = wl[ai * HALF + m * 16]; }
#pragma unroll
        for (int ai = 0; ai < 2; ++ai)
#pragma unroll
            for (int m = 0; m < 4; ++m) { const int a = a8[ai][m]; const float w = w8[ai][m]; unsigned char* rowp = (a >= 0 ? Y + (size_t)a * D : sink) + col0;
                { v4u o; o.x = pack4_fp8(acc[ai][0][m][0] * w); o.y = pack4_fp8(acc[ai][0][m][1] * w); o.z = pack4_fp8(acc[ai][1][m][0] * w); o.w = pack4_fp8(acc[ai][1][m][1] * w); *(v4u*)rowp = o; }
                asm volatile("" ::: "memory"); }
    }
};

typedef int v8i __attribute__((ext_vector_type(8))); typedef int v4i __attribute__((ext_vector_type(4)));
template <int MODE> struct AccT { typedef f32x4 type; }; template <> struct AccT<2> { typedef v4i type; };
template <class Epi, class Sched, int MODE = 0>
__device__ __forceinline__ void gemm_phase(LAS unsigned char* lds, const Sched& S, const Epi& E) {
    const int tid = threadIdx.x, wid = __builtin_amdgcn_readfirstlane(tid >> 6), lane = tid & 63, wr = wid >> 2, wc = wid & 3, fr = lane & 15, fq = lane >> 4;
    const int K = S.K, nt = K / BK;
    int R0, C0; stage_rc(tid * 16, R0, C0);
    const int Rb0 = Epi::PERM ? ((R0 & ~31) + perm32(R0 & 31)) : R0;
    unsigned voffA[2], voffB[2];
#pragma unroll
    for (int i = 0; i < 2; ++i) { voffA[i] = (unsigned)((R0 + 64 * i) * K + C0) * 2u; voffB[i] = (unsigned)((Rb0 + 64 * i) * K + C0) * 2u; }
    unsigned voffB16[2][2] = {{0u, 0u}, {0u, 0u}};
    if constexpr (Epi::PERM16) {
#pragma unroll
        for (int h = 0; h < 2; ++h)
#pragma unroll
            for (int i = 0; i < 2; ++i) { const int R = R0 + 64 * i; voffB16[h][i] = (unsigned)((64 * (R >> 5) + 16 * ((R >> 2) & 3) + 8 * h + 4 * ((R >> 4) & 1) + (R & 3)) * K + C0) * 2u; } }
    const size_t kstep = (size_t)(BK * 2);
    const size_t hstep = (size_t)HALF * K * 2;
    const unsigned ldsb = (unsigned)__builtin_amdgcn_readfirstlane((int)((unsigned)(size_t)lds + (unsigned)wid * 1024u));
    const int aoff = lds_byte(wr * 64 + fr, fq * 8), boff = lds_byte(wc * 32 + fr, fq * 8);
#define PG8_SA(b, h) (((b) * 2 + (h)) * HTB)
#define PG8_SB(b, h) ((4 + (b) * 2 + (h)) * HTB)
#define PG8_GLDS(sbase, voff32, ldsdst) asm volatile("s_mov_b32 m0, %2\n\ts_nop 0\n\tglobal_load_lds_dwordx4 %0, %1" :: "v"(voff32), "s"(sbase), "s"(ldsdst) : "memory", "m0")
#define PG8_STAGE_B(bufoff, gbase, h) do { if constexpr (Epi::PERM16) { PG8_GLDS((const char*)(gbase), voffB16[h][0], ldsb + (bufoff)); PG8_GLDS((const char*)(gbase), voffB16[h][1], ldsb + (bufoff) + 8192u); } \
        else { PG8_GLDS((const char*)(gbase) + (h) * hstep, voffB[0], ldsb + (bufoff)); PG8_GLDS((const char*)(gbase) + (h) * hstep, voffB[1], ldsb + (bufoff) + 8192u); } } while (0)
#define PG8_STAGE_A(bufoff, dbase, offs, h, kb) do { if constexpr (Sched::GATHER) { PG8_GLDS(S.a_origin() + (kb), offs[h][0], ldsb + (bufoff)); PG8_GLDS(S.a_origin() + (kb), offs[h][1], ldsb + (bufoff) + 8192u); } \
        else { PG8_GLDS((dbase) + (h) * hstep + (kb), voffA[0], ldsb + (bufoff)); PG8_GLDS((dbase) + (h) * hstep + (kb), voffA[1], ldsb + (bufoff) + 8192u); } } while (0)
#define PG8_LDA(dst, b, h) do { _Pragma("unroll") for (int m = 0; m < 4; ++m) { const v4i _lo = *(const LAS v4i*)(lds + PG8_SA(b, h) + aoff + m * 2048), _hi = *(const LAS v4i*)(lds + PG8_SA(b, h) + aoff + m * 2048 + 1024); dst[m] = __builtin_shufflevector(_lo, _hi, 0, 1, 2, 3, 4, 5, 6, 7); } } while (0)
#define PG8_LDB(dst, b, h) do { _Pragma("unroll") for (int n = 0; n < 2; ++n) { const v4i _lo = *(const LAS v4i*)(lds + PG8_SB(b, h) + boff + n * 2048), _hi = *(const LAS v4i*)(lds + PG8_SB(b, h) + boff + n * 2048 + 1024); dst[n] = __builtin_shufflevector(_lo, _hi, 0, 1, 2, 3, 4, 5, 6, 7); } } while (0)
#define PG8_MMA(ai, bj, At, Bt) do { __builtin_amdgcn_s_setprio(1); _Pragma("unroll") for (int m = 0; m < 4; ++m) _Pragma("unroll") for (int n = 0; n < 2; ++n) { \
        if constexpr (MODE == 1) acc[ai][bj][m][n] = __builtin_amdgcn_mfma_scale_f32_16x16x128_f8f6f4(Bt[n], At[m], acc[ai][bj][m][n], 0, 0, 0, 0, 0, 0);     \
        else { const v4i _b0 = __builtin_shufflevector(Bt[n], Bt[n], 0, 1, 2, 3), _b1 = __builtin_shufflevector(Bt[n], Bt[n], 4, 5, 6, 7), _a0 = __builtin_shufflevector(At[m], At[m], 0, 1, 2, 3), _a1 = __builtin_shufflevector(At[m], At[m], 4, 5, 6, 7); \
            if constexpr (MODE == 2) { acc[ai][bj][m][n] = __builtin_amdgcn_mfma_i32_16x16x64_i8(_b0, _a0, acc[ai][bj][m][n], 0, 0, 0); acc[ai][bj][m][n] = __builtin_amdgcn_mfma_i32_16x16x64_i8(_b1, _a1, acc[ai][bj][m][n], 0, 0, 0); } \
            else { acc[ai][bj][m][n] = __builtin_amdgcn_mfma_f32_16x16x32_bf16(__builtin_bit_cast(bf16x8, _b0), __builtin_bit_cast(bf16x8, _a0), acc[ai][bj][m][n], 0, 0, 0); \
                   acc[ai][bj][m][n] = __builtin_amdgcn_mfma_f32_16x16x32_bf16(__builtin_bit_cast(bf16x8, _b1), __builtin_bit_cast(bf16x8, _a1), acc[ai][bj][m][n], 0, 0, 0); } } } __builtin_amdgcn_s_setprio(0); } while (0)
#define PG8_WAIT_V(n) asm volatile("s_waitcnt vmcnt(" #n ")" ::: "memory")
#define PG8_WAIT_L(n) asm volatile("s_waitcnt lgkmcnt(" #n ")" ::: "memory")
#define PG8_BAR __builtin_amdgcn_s_barrier()
#define PG8_SCHED __builtin_amdgcn_sched_barrier(0)
    Unit cur, nxt, nn;
    if (!S.next(0, cur)) return;
    bool has_next = S.next(1, nxt);
    if (!has_next) nxt = cur;
    typedef typename AccT<MODE>::type acc_t;
    acc_t acc[2][2][4][2];
#pragma unroll
    for (int a = 0; a < 2; ++a)
#pragma unroll
        for (int b = 0; b < 2; ++b)
#pragma unroll
            for (int m = 0; m < 4; ++m)
#pragma unroll
                for (int n = 0; n < 2; ++n) acc[a][b][m][n] = (acc_t){0, 0, 0, 0};
    v8i At[4], B0[2], B1[2];
    unsigned offC[2][2] = {{0u, 0u}, {0u, 0u}}, offN[2][2] = {{0u, 0u}, {0u, 0u}};
    if constexpr (Sched::GATHER) { S.a_offs(cur, R0, C0 * 2, offC); S.a_offs(nxt, R0, C0 * 2, offN); }
    const char* cA = S.a_base(cur); const char* cB = S.b_base(cur);
    int ui = 0;
    LAS unsigned char* rowb = lds + EPI_ROW_OFF; LAS float* biasl = (LAS float*)(lds + EPI_BIAS_OFF);
    typename Epi::Row rowd;
    PG8_STAGE_B(PG8_SB(0, 0), cB, 0); PG8_STAGE_B(PG8_SB(0, 1), cB, 1); PG8_STAGE_A(PG8_SA(0, 0), cA, offC, 0, 0); PG8_STAGE_A(PG8_SA(0, 1), cA, offC, 1, 0);
    E.stage(biasl, tid); E.row_load(cur, tid, rowd); E.row_store(rowb, tid, rowd);
    if (wr == 1) PG8_BAR;
    PG8_WAIT_V(2); PG8_BAR;
    PG8_STAGE_B(PG8_SB(1, 0), cB + kstep, 0); PG8_STAGE_A(PG8_SA(1, 0), cA, offC, 0, kstep); PG8_STAGE_B(PG8_SB(1, 1), cB + kstep, 1);
    PG8_WAIT_V(6); PG8_BAR;
    for (;;) {
        const char* nA = S.a_base(nxt); const char* nB = S.b_base(nxt);
#pragma unroll 1
        for (int t = 0; t < nt; t += 2) {
            const bool last = (t == nt - 2);
            const size_t k1 = (size_t)(t + 1) * kstep;
            const size_t k2 = last ? 0 : (size_t)(t + 2) * kstep, k3 = k2 + kstep;
            const char* a2 = last ? nA : cA; const char* b2 = (last ? nB : cB) + k2; const char* b3 = b2 + kstep;
            PG8_LDB(B0, 0, 0); PG8_LDB(B1, 0, 1); PG8_SCHED; PG8_LDA(At, 0, 0); PG8_STAGE_A(PG8_SA(1, 1), cA, offC, 1, k1);
            if constexpr (Sched::GATHER) { if (last) {
#pragma unroll
                for (int h = 0; h < 2; ++h)
#pragma unroll
                    for (int i = 0; i < 2; ++i) offC[h][i] = offN[h][i]; } }
            PG8_WAIT_V(8); PG8_WAIT_L(0); PG8_BAR; PG8_MMA(0, 0, At, B0); PG8_MMA(0, 1, At, B1); PG8_BAR; PG8_SCHED;
            PG8_LDA(At, 0, 1); PG8_STAGE_B(PG8_SB(0, 0), b2, 0); PG8_STAGE_B(PG8_SB(0, 1), b2, 1); PG8_STAGE_A(PG8_SA(0, 0), a2, offC, 0, k2);
            PG8_WAIT_V(8); PG8_WAIT_L(0); PG8_BAR; PG8_MMA(1, 0, At, B0); PG8_MMA(1, 1, At, B1); PG8_BAR; PG8_SCHED;
            PG8_LDB(B0, 1, 0); PG8_LDB(B1, 1, 1); PG8_SCHED; PG8_LDA(At, 1, 0); PG8_STAGE_A(PG8_SA(0, 1), a2, offC, 1, k2);
            PG8_WAIT_V(8); PG8_WAIT_L(0); PG8_BAR; PG8_MMA(0, 0, At, B0); PG8_MMA(0, 1, At, B1); PG8_BAR; PG8_SCHED;
            PG8_LDA(At, 1, 1); PG8_STAGE_B(PG8_SB(1, 0), b3, 0); PG8_STAGE_B(PG8_SB(1, 1), b3, 1); PG8_STAGE_A(PG8_SA(1, 0), a2, offC, 0, k3);
            PG8_WAIT_V(8); PG8_WAIT_L(0); PG8_BAR; PG8_MMA(1, 0, At, B0); PG8_MMA(1, 1, At, B1); PG8_BAR; PG8_SCHED;
        }
        if (wr == 0) PG8_BAR;
        bool has_nn = false;
        unsigned rawN[2][2] = {{0u, 0u}, {0u, 0u}};
        if (has_next) { E.row_load(nxt, tid, rowd); has_nn = S.next(ui + 2, nn); if (!has_nn) nn = nxt; if constexpr (Sched::GATHER) S.a_offs_load(nn, R0, rawN); }
        { int fr_ = fr, fq_ = fq; asm volatile("" : "+v"(fr_), "+v"(fq_));
          if constexpr (MODE == 2) { f32x4 accf[2][2][4][2];
#pragma unroll
              for (int a = 0; a < 2; ++a)
#pragma unroll
                  for (int b = 0; b < 2; ++b)
#pragma unroll
                      for (int m = 0; m < 4; ++m)
#pragma unroll
                          for (int n = 0; n < 2; ++n) accf[a][b][m][n] = __builtin_convertvector(acc[a][b][m][n], f32x4);
              E(accf, cur, wr, wc, fr_, fq_, rowb + (ui & 1) * 2048, biasl); }
          else E(acc, cur, wr, wc, fr_, fq_, rowb + (ui & 1) * 2048, biasl); }
        if (has_next) E.row_store(rowb + ((ui + 1) & 1) * 2048, tid, rowd);
        if constexpr (Sched::GATHER) { asm volatile("" : "+v"(rawN[0][0]), "+v"(rawN[0][1]), "+v"(rawN[1][0]), "+v"(rawN[1][1]) :: "memory");
            if (has_next) S.a_offs_finish(nn, R0, C0 * 2, rawN, offN); asm volatile("" : "+v"(offN[0][0]), "+v"(offN[0][1]), "+v"(offN[1][0]), "+v"(offN[1][1])); }
        if (!has_next) break;
#pragma unroll
        for (int a = 0; a < 2; ++a)
#pragma unroll
            for (int b = 0; b < 2; ++b)
#pragma unroll
                for (int m = 0; m < 4; ++m)
#pragma unroll
                    for (int n = 0; n < 2; ++n) acc[a][b][m][n] = (acc_t){0, 0, 0, 0};
        cur = nxt; cA = nA; cB = nB; nxt = nn; has_next = has_nn; ++ui;
        if (wr == 1) PG8_BAR;
    }
    PG8_WAIT_V(0);
    PG8_BAR;
#undef PG8_SA
#undef PG8_SB
#undef PG8_GLDS
#undef PG8_STAGE_A
#undef PG8_STAGE_B
#undef PG8_LDA
#undef PG8_LDB
#undef PG8_MMA
#undef PG8_WAIT_V
#undef PG8_WAIT_L
#undef PG8_BAR
#undef PG8_SCHED
}
}

#define XB_TMO      128
#define XB_XCNT(j)  (256  + 64 * (j))
#define XB_XSUB(j)  (1280 + 64 * (j))
#define XB_XGEN(j)  (2304 + 64 * (j))
#define XB_TOP      3328
#define XB_TOPGEN   3392
#define XCD_BAR_WORDS 3456
#define XB_SPIN_CAP (1u << 18)

__device__ __forceinline__ unsigned xb_ld(unsigned* p)              { return __hip_atomic_load(p, __ATOMIC_RELAXED, __HIP_MEMORY_SCOPE_AGENT); }
__device__ __forceinline__ unsigned xb_add(unsigned* p, unsigned v) { return __hip_atomic_fetch_add(p, v, __ATOMIC_RELAXED, __HIP_MEMORY_SCOPE_AGENT); }
__device__ __forceinline__ unsigned xb_xcc_id() { return (unsigned)__builtin_amdgcn_s_getreg((3 << 11) | 20) & 0xFu; }
#define XB_SPIN(cond, bar) do { unsigned _sp = 0; while (cond) { __builtin_amdgcn_s_sleep(1); \
    if ((++_sp & 255u) == 0u) { if (xb_ld(&(bar)[XB_TMO])) break; if (_sp > XB_SPIN_CAP) { atomicAdd(&(bar)[XB_TMO], 1u); break; } } } } while (0)

struct XcdBarrier {
    unsigned* bar; unsigned x;
    volatile LAS unsigned* st;
};

__device__ __forceinline__ XcdBarrier xcd_barrier_post(unsigned* bar, volatile LAS unsigned* st) {
    XcdBarrier b; b.bar = bar; b.x = xb_xcc_id(); b.st = st;
    if (threadIdx.x == 0) (void)xb_add(&bar[XB_XCNT(b.x)], 1u);
    return b;
}
__device__ __forceinline__ void xcd_barrier_complete(unsigned* bar, unsigned x, unsigned& nloc, unsigned& nx) {
    const unsigned G = gridDim.x * gridDim.y * gridDim.z;
    unsigned sum, cnt, mine, sp = 0u;
    for (;;) {
        sum = 0u; cnt = 0u; mine = 0u;
#pragma unroll
        for (unsigned j = 0; j < 16; ++j) { const unsigned c = xb_ld(&bar[XB_XCNT(j)]); sum += c; cnt += (c > 0u) ? 1u : 0u; mine = (j == x) ? c : mine; }
        if (sum == G) break;
        __builtin_amdgcn_s_sleep(1);
        if ((++sp & 255u) == 0u) { if (xb_ld(&bar[XB_TMO])) break; if (sp > XB_SPIN_CAP) { atomicAdd(&bar[XB_TMO], 1u); break; } }
    }
    nloc = mine > 0u ? mine : 1u; nx = cnt > 0u ? cnt : 1u;
}

__device__ __forceinline__ void xcd_barrier(const XcdBarrier& b) {
    asm volatile("s_waitcnt vmcnt(0)" ::: "memory");
    __syncthreads();
    if (threadIdx.x == 0) {
        unsigned* bar = b.bar;
        __builtin_amdgcn_s_waitcnt(0);
        unsigned nloc = b.st[0], nx = b.st[1];
        if (nloc == 0u) { xcd_barrier_complete(bar, b.x, nloc, nx); b.st[0] = nloc; b.st[1] = nx; }
        const unsigned old = xb_add(&bar[XB_XSUB(b.x)], 1u);
        const unsigned gen = old / nloc;
        if (old + 1u == (gen + 1u) * nloc) {
            __builtin_amdgcn_fence(__ATOMIC_RELEASE, "agent");
            asm volatile("s_waitcnt vmcnt(0)" ::: "memory");
            const unsigned og = xb_add(&bar[XB_TOP], 1u);
            const unsigned tg = og / nx;
            if (og + 1u == (tg + 1u) * nx) xb_add(&bar[XB_TOPGEN], 1u);
            else XB_SPIN(xb_ld(&bar[XB_TOPGEN]) == tg, bar);
            __builtin_amdgcn_fence(__ATOMIC_ACQUIRE, "agent");
            xb_add(&bar[XB_XGEN(b.x)], 1u);
            asm volatile("s_waitcnt vmcnt(0)" ::: "memory");
        } else {
            XB_SPIN(xb_ld(&bar[XB_XGEN(b.x)]) == gen, bar);
            __builtin_amdgcn_fence(__ATOMIC_ACQUIRE, "agent");
            asm volatile("s_waitcnt vmcnt(0)" ::: "memory");
        }
    }
    __syncthreads();
}

enum { PH_PRO = 0, PH_PRO2, PH_PW1, PH_CONV, PH_PW2, PH_ROUTE0, PH_MOEGU0, PH_MOEDN0, PH_COMB0, PH_WIN, PH_SGU, PH_WOUT, PH_ROUTE1, PH_MOEGU1, PH_MOEDN1, PH_FINAL, N_PHASES };
constexpr int FULL_MASK = (1 << N_PHASES) - 1;
#ifndef PROBE_BUILD
#define PROBE_BUILD 0
#endif
constexpr int MISC_OFF = RING_BYTES + 320, LDS_BYTES = 155648;

template <int LAYER> __device__ __forceinline__ void moe_gu_phase(Frame& F, bool ride_late = false, bool ride_wd = false) {
    pg8::MoeOrder<true> S; S.init(F.ws + WS_XN8, F.ws + WS_WGU, (const int*)(F.ws + WS_LIST), ctl(F) + CW_CNT + LAYER * 32 * 64, D / 2, F.nwg, F.wg, F.lane, F.wave, (LAS unsigned*)(F.lds + RING_BYTES + 1024));
    pg8::FEpiMoeGU E{F.ws + WS_A};
    pg8::gemm_phase<pg8::FEpiMoeGU, pg8::MoeOrder<true>, 1>(F.lds, S, E);
    if (ride_late) {
        const int G = F.nwg, tot = (int)S.tab[32] * 4, rounds = (tot + G - 1) / G, lastcnt = tot - (rounds - 1) * G;
        const int slot = (F.wg & 7) * (G >> 3) + (F.wg >> 3);
        __syncthreads();
        if (lastcnt >= G || lastcnt <= 0) dense_late_items(F, slot, G);
        else if (slot >= lastcnt) dense_late_items(F, slot - lastcnt, G - lastcnt);
    }
    if (ride_wd) {
        const int G = F.nwg, tot = (int)S.tab[32] * 4, rounds = (tot + G - 1) / G, lastcnt = tot - (rounds - 1) * G;
        const int slot = (F.wg & 7) * (G >> 3) + (F.wg >> 3), nidle = G - lastcnt;
        if (lastcnt <= 0 || lastcnt >= G || nidle * 4 < G) convert_moe_layer(F, LAYER, 2, slot, G);
        else if (slot >= lastcnt) convert_moe_layer(F, LAYER, 2, slot - lastcnt, nidle);
    }
}
template <int LAYER> __device__ __forceinline__ void moe_dn_phase(Frame& F, bool reuse_tab, bool ride_win = false) {
    pg8::MoeOrder<false> S; S.init(F.ws + WS_A, F.ws + WS_WD, (const int*)(F.ws + WS_LIST), ctl(F) + CW_CNT + LAYER * 32 * 64, DE / 2, F.nwg, F.wg, F.lane, F.wave, (LAS unsigned*)(F.lds + RING_BYTES + 1024), reuse_tab);
    pg8::FEpiMoeDown E{F.ws + WS_B, (const int*)(F.ws + WS_LIST), (const float*)(F.ws + WS_GWL), F.ws + WS_SINK};
    pg8::gemm_phase<pg8::FEpiMoeDown, pg8::MoeOrder<false>, 1>(F.lds, S, E);
    if (ride_win) {
        const int G = F.nwg, tot = (int)S.tab[32] * 4, rounds = (tot + G - 1) / G, lastcnt = tot - (rounds - 1) * G;
        const int slot = (F.wg & 7) * (G >> 3) + (F.wg >> 3);
        __syncthreads();
        if (lastcnt >= G || lastcnt <= 0) convert_win_i8(F, slot, G);
        else if (slot >= lastcnt) convert_win_i8(F, slot - lastcnt, G - lastcnt);
    }
}

template <int PMASK> __global__ void __launch_bounds__(NTHREADS, 2) k_fused(Params p) {
    extern __shared__ __attribute__((aligned(16))) unsigned char lds[];
    Frame F; F.lds = (LAS unsigned char*)lds; F.tid = threadIdx.x; F.lane = F.tid & 63; F.wave = __builtin_amdgcn_readfirstlane(F.tid >> 6);
    F.wg = blockIdx.x; F.nwg = gridDim.x; F.p = p; F.ws = p.ws;
    volatile LAS unsigned* MISC = (volatile LAS unsigned*)(F.lds + MISC_OFF);
    if (F.tid < 32) MISC[F.tid] = 0u;
    __syncthreads();
    const int lo = p.ph_lo, hi = p.ph_hi;
    const bool multi = hi - lo > 1;
    const bool dry = PROBE_BUILD && (p.dry != 0);
    XcdBarrier bar; bar.bar = ctl(F) + CW_BAR; bar.x = 0; bar.st = MISC + 8;
    if (multi) bar = xcd_barrier_post(ctl(F) + CW_BAR, MISC + 8);
#define IN(k) (((PMASK >> (k)) & 1) && lo <= (k) && (k) < hi)
#define SEAM(k) do { if (IN(k) && IN((k) + 1)) xcd_barrier(bar); else __syncthreads(); } while (0)
    unsigned char* ws = F.ws;
    if (IN(PH_PRO)) { phase_prologue(F, !IN(PH_MOEGU0)); } SEAM(PH_PRO);
    if (IN(PH_PRO2)) { phase_prologue2(F); } SEAM(PH_PRO2);
    if (IN(PH_PW1)) { const bool cfirst = (F.wg >> 3) & 1;
        if (cfirst) convert_moe_layer(F, 0, 0, F.wg, F.nwg);
        pg8::DenseOrderG S; S.init(ws + WS_XN, ws + WS_W1T, T, 2048, D / 2, F.nwg, F.wg);
        pg8::FEpiGlu E{(bf16*)(ws + WS_A), p.in[I_CB1], (const float*)(ws + WS_RROW), (const unsigned*)(ctl(F) + CW_WMAX + WL_W1 * 16)}; pg8::gemm_phase<pg8::FEpiGlu, pg8::DenseOrderG, 2>(F.lds, S, E);
        if (!cfirst) convert_moe_layer(F, 0, 0, F.wg, F.nwg); } SEAM(PH_PW1);
    if (IN(PH_CONV)) { phase_conv(F); } SEAM(PH_CONV);
    if (IN(PH_PW2)) { pg8::DenseOrderG S; S.init(ws + WS_A + 64 * MiB, ws + WS_W2T, T, D, D / 2, F.nwg, F.wg);
        pg8::FEpiBf16SX E{(bf16*)(ws + WS_H), p.in[I_CB2], (const float*)(ws + WS_RROW), (const unsigned*)(ctl(F) + CW_WMAX + WL_W2 * 16), p.in[I_X]}; pg8::gemm_phase<pg8::FEpiBf16SX, pg8::DenseOrderG, 2>(F.lds, S, E); } SEAM(PH_PW2);
    if (IN(PH_ROUTE0)) { phase_route<false, true>(F, 0, dry ? 2 : 0, ws + WS_H, nullptr); } SEAM(PH_ROUTE0);
    if (IN(PH_MOEGU0)) { moe_gu_phase<0>(F, IN(PH_PRO)); } SEAM(PH_MOEGU0);
    if (IN(PH_MOEDN0)) { moe_dn_phase<0>(F, IN(PH_MOEGU0), IN(PH_COMB0)); } SEAM(PH_MOEDN0);
    if (IN(PH_COMB0)) { if ((!PROBE_BUILD || p.dry != 2) && !IN(PH_MOEDN0)) { convert_win_i8(F, F.wg, F.nwg); }     if (!PROBE_BUILD || p.dry != 3) phase_combine<false>(F, p.in[I_NMG] + D, dry); } SEAM(PH_COMB0);
    if (IN(PH_WIN)) { const bool cfirst = (F.wg >> 3) & 1;
        const int sel1 = IN(PH_MOEGU1) ? 1 : 0;
        if (cfirst) convert_moe_layer(F, 1, sel1, F.wg, F.nwg);
        pg8::DenseOrderG S; S.init(ws + WS_XN, ws + WS_WINT, T, 4096, D / 2, F.nwg, F.wg);
        pg8::FEpiGeluUV E{(bf16*)(ws + WS_A), (bf16*)(ws + WS_B), (float*)(ws + WS_SSQ), p.in[I_GBIN], (const float*)(ws + WS_RROW), (const unsigned*)(ctl(F) + CW_WMAX + WL_WIN * 16)}; pg8::gemm_phase<pg8::FEpiGeluUV, pg8::DenseOrderG, 2>(F.lds, S, E);
        if (!cfirst) convert_moe_layer(F, 1, sel1, F.wg, F.nwg); } SEAM(PH_WIN);
    if (IN(PH_SGU)) { phase_sgu(F, dry); } SEAM(PH_SGU);
    if (IN(PH_WOUT)) { __builtin_amdgcn_s_waitcnt(0);
        pg8::DenseOrderG S; S.init(ws + WS_XN, ws + WS_WOUTT, T, D, GI / 2, F.nwg, F.wg); pg8::FEpiBf16R E{(bf16*)(ws + WS_H), p.in[I_GBOUT]}; pg8::gemm_phase<pg8::FEpiBf16R, pg8::DenseOrderG, 1>(F.lds, S, E); } SEAM(PH_WOUT);
    if (IN(PH_ROUTE1)) { phase_route<false, true>(F, 1, 1, ws + WS_H, nullptr); } SEAM(PH_ROUTE1);
    if (IN(PH_MOEGU1)) { moe_gu_phase<1>(F, false, IN(PH_WIN)); } SEAM(PH_MOEGU1);
    if (IN(PH_MOEDN1)) { moe_dn_phase<1>(F, IN(PH_MOEGU1)); } SEAM(PH_MOEDN1);
    if (IN(PH_FINAL)) { phase_combine<true>(F, p.in[I_FG], dry); }
#undef IN
#undef SEAM
}

#ifndef REPEAT_PHASE
#define REPEAT_PHASE -1
#endif
template <int PH> static void launch_one(Params p, int dry, hipStream_t stream) {
    static bool attr = false;
    if (!attr) { (void)hipFuncSetAttribute((const void*)k_fused<(1 << PH)>, hipFuncAttributeMaxDynamicSharedMemorySize, LDS_BYTES); attr = true; }
    p.ph_lo = PH; p.ph_hi = PH + 1; p.dry = dry;
    hipLaunchKernelGGL(k_fused<(1 << PH)>, dim3(256), dim3(NTHREADS), LDS_BYTES, stream, p);
}
template <int PH> static void launch_probe(const Params& p, hipStream_t stream) {
    if constexpr (PROBE_BUILD != 0) {
        constexpr bool inplace = (PH == PH_COMB0 || PH == PH_SGU || PH == PH_FINAL || PH == PH_ROUTE0 || PH == PH_ROUTE1);
        if (REPEAT_PHASE == PH) launch_one<PH>(p, inplace ? (PH == PH_COMB0 ? 2 : 1) : 0, stream);
        if (REPEAT_PHASE == 100 + PH && PH == PH_COMB0) launch_one<PH>(p, 3, stream);
        launch_one<PH>(p, 0, stream);
    }
}

extern "C" void kernel_launch(void* const* d_in, const int* in_sizes, int n_in, void* d_out, int out_size, void* d_ws, size_t ws_size, hipStream_t stream) {
    if (n_in != N_IN || out_size != T * D || ws_size < WS_END) { fprintf(stderr, "kernel_launch: unexpected shapes (n_in %d out %d ws %zu)\n", n_in, out_size, ws_size); return; }
    (void)in_sizes;
    Params p{};
    for (int i = 0; i < N_IN; ++i) p.in[i] = (const float*)d_in[i];
    p.out = (float*)d_out; p.ws = (unsigned char*)d_ws;
    unsigned char* ws = (unsigned char*)d_ws;
    (void)hipMemsetAsync(ws + WS_CTL, 0, CTL_ZERO_BYTES, stream);
    static int grid = 0;
    if (!grid) { int dev = 0, cus = 0; if (hipGetDevice(&dev) != hipSuccess || hipDeviceGetAttribute(&cus, hipDeviceAttributeMultiprocessorCount, dev) != hipSuccess || cus <= 0) cus = 256; grid = (cus < 256 ? cus : 256) & ~7; if (grid < 8) grid = 8; }
    if constexpr (PROBE_BUILD == 0) {
        static bool attr = false;
        if (!attr) { if (hipFuncSetAttribute((const void*)k_fused<FULL_MASK>, hipFuncAttributeMaxDynamicSharedMemorySize, LDS_BYTES) != hipSuccess) fprintf(stderr, "kernel_launch: hipFuncSetAttribute failed\n"); attr = true; }
        p.ph_lo = 0; p.ph_hi = N_PHASES; p.dry = 0;
        hipLaunchKernelGGL(k_fused<FULL_MASK>, dim3(grid), dim3(NTHREADS), LDS_BYTES, stream, p);
        return;
    }
    if constexpr (PROBE_BUILD != 0) {
    launch_probe<PH_PRO>(p, stream); launch_probe<PH_PRO2>(p, stream); launch_probe<PH_PW1>(p, stream); launch_probe<PH_CONV>(p, stream); launch_probe<PH_PW2>(p, stream); launch_probe<PH_ROUTE0>(p, stream);
    launch_probe<PH_MOEGU0>(p, stream); launch_probe<PH_MOEDN0>(p, stream); launch_probe<PH_COMB0>(p, stream); launch_probe<PH_WIN>(p, stream); launch_probe<PH_SGU>(p, stream);
    launch_probe<PH_WOUT>(p, stream); launch_probe<PH_ROUTE1>(p, stream); launch_probe<PH_MOEGU1>(p, stream); launch_probe<PH_MOEDN1>(p, stream); launch_probe<PH_FINAL>(p, stream);
    }
}
```
